# Optimizing an MI355X kernel written in HIP

```python
import math
import jax, jax.numpy as jnp
from jax import lax
import numpy as np

D_MODEL = 1024
BATCH = 8
SEQ = 2048
DEPTH = 1

D_CONV = D_MODEL
CONV_K = 3
HEAD_DIM = 64
N_HEADS = 16
N_KV_HEADS = 4
GROUP = N_HEADS // N_KV_HEADS
D_ATTN = N_HEADS * HEAD_DIM
D_KV = N_KV_HEADS * HEAD_DIM
WINDOW = 128
BLOCK = 128
ROT_DIM = HEAD_DIM // 4
ROPE_THETA = 500000.0
ATTN_SCALE = 1.0 / math.sqrt(HEAD_DIM)
NEG_INF = -1e30
D_FF = ((8 * D_MODEL // 3 + 255) // 256) * 256
EPS = 1e-5

IN_WIDTHS = (D_CONV, D_CONV, D_CONV, D_ATTN, D_KV, D_KV, D_MODEL, D_MODEL)
N_IN = sum(IN_WIDTHS)
SPLIT_POINTS = tuple(int(v) for v in np.cumsum(IN_WIDTHS)[:-1])

kernel_name = "hybrid_gated_conv_swa_sink_block"


def rms_norm(x, g):
    xf = x.astype(jnp.float32)
    y = xf * lax.rsqrt(jnp.mean(xf * xf, axis=-1, keepdims=True) + EPS)
    return (y * g.astype(jnp.float32)).astype(x.dtype)


def rotary_tables(seq, dtype):
    inv_freq = ROPE_THETA ** (-jnp.arange(0, ROT_DIM, 2, dtype=jnp.float32) / ROT_DIM)
    ang = jnp.arange(seq, dtype=jnp.float32)[:, None] * inv_freq[None, :]
    return jnp.cos(ang).astype(dtype), jnp.sin(ang).astype(dtype)


def partial_rotary(t, cos, sin):
    rot, rest = t[..., :ROT_DIM], t[..., ROT_DIM:]
    r1, r2 = rot[..., :ROT_DIM // 2], rot[..., ROT_DIM // 2:]
    c = cos[None, :, None, :]
    s = sin[None, :, None, :]
    rot = jnp.concatenate([r1 * c - r2 * s, r2 * c + r1 * s], axis=-1)
    return jnp.concatenate([rot, rest], axis=-1)


def causal_depthwise_conv(u, w):
    rhs = w[:, None, :].astype(u.dtype)
    return lax.conv_general_dilated(
        u, rhs, window_strides=(1,), padding=[(CONV_K - 1, 0)],
        dimension_numbers=('NWC', 'WIO', 'NWC'), feature_group_count=u.shape[-1])


def sliding_window_sink_attention(q, k, v, sinks):
    b, s = q.shape[0], q.shape[1]
    nb = s // BLOCK
    qb = q.reshape(b, nb, BLOCK, N_KV_HEADS, GROUP, HEAD_DIM)

    def band(t):
        tp = jnp.pad(t, ((0, 0), (BLOCK, 0), (0, 0), (0, 0)))
        tp = tp.reshape(b, nb + 1, BLOCK, N_KV_HEADS, HEAD_DIM)
        return jnp.concatenate([tp[:, :-1], tp[:, 1:]], axis=2)

    kb, vb = band(k), band(v)
    scores = jnp.einsum('bnqhgd,bnkhd->bnhgqk', qb, kb,
                        preferred_element_type=jnp.float32) * ATTN_SCALE
    qi = jnp.arange(BLOCK)[:, None]
    kj = jnp.arange(2 * BLOCK)[None, :]
    rel = qi + BLOCK - kj
    in_window = (rel >= 0) & (rel < WINDOW)
    key_pos = jnp.arange(nb)[:, None] * BLOCK - BLOCK + jnp.arange(2 * BLOCK)[None, :]
    mask = in_window[None] & (key_pos >= 0)[:, None, :]
    scores = jnp.where(mask[None, :, None, None], scores, NEG_INF)
    sink = jnp.broadcast_to(sinks.astype(jnp.float32).reshape(1, 1, N_KV_HEADS, GROUP, 1, 1),
                            scores.shape[:-1] + (1,))
    probs = jax.nn.softmax(jnp.concatenate([scores, sink], axis=-1), axis=-1)[..., :-1]
    out = jnp.einsum('bnhgqk,bnkhd->bnqhgd', probs.astype(v.dtype), vb)
    return out.reshape(b, s, D_ATTN)


def setup_inputs(seed: int = 0) -> dict:
    key = jax.random.key(seed)
    ks = jax.random.split(key, 13)
    f32 = jnp.float32

    def w(k, shape, fan_in):
        return jax.random.normal(k, shape, f32) * (fan_in ** -0.5)

    def gain(k, shape):
        return 1.0 + 0.05 * jax.random.normal(k, shape, f32)

    return {
        "x": jax.random.normal(ks[0], (BATCH, SEQ, D_MODEL), f32),
        "g_mix": gain(ks[1], (DEPTH, D_MODEL)),
        "w_in": w(ks[2], (DEPTH, D_MODEL, N_IN), D_MODEL),
        "conv_w": w(ks[3], (DEPTH, CONV_K, D_CONV), CONV_K),
        "attn_sinks": 0.5 * jax.random.normal(ks[4], (DEPTH, N_HEADS), f32),
        "w_conv_out": w(ks[5], (DEPTH, D_CONV, D_MODEL), D_CONV),
        "w_attn_out": w(ks[6], (DEPTH, D_ATTN, D_MODEL), D_ATTN),
        "w_o": w(ks[7], (DEPTH, D_MODEL, D_MODEL), D_MODEL),
        "g_ffn": gain(ks[8], (DEPTH, D_MODEL)),
        "w_gate_up": w(ks[9], (DEPTH, D_MODEL, 2 * D_FF), D_MODEL),
        "w_down": w(ks[10], (DEPTH, D_FF, D_MODEL), D_FF),
        "g_final": gain(ks[11], (D_MODEL,)),
    }


def reference(x, g_mix, w_in, conv_w, attn_sinks, w_conv_out, w_attn_out, w_o,
              g_ffn, w_gate_up, w_down, g_final):
    b, s, _ = x.shape
    cos, sin = rotary_tables(s, x.dtype)
    for l in range(DEPTH):
        h = rms_norm(x, g_mix[l])
        proj = jnp.einsum('bsd,dn->bsn', h, w_in[l])
        cb, cc, cx, q, k, v, gate_c, gate_a = jnp.split(proj, SPLIT_POINTS, axis=-1)

        conv_y = cb * causal_depthwise_conv(cc * cx, conv_w[l])
        conv_out = jnp.einsum('bsc,cd->bsd', conv_y, w_conv_out[l])

        q = partial_rotary(q.reshape(b, s, N_HEADS, HEAD_DIM), cos, sin)
        k = partial_rotary(k.reshape(b, s, N_KV_HEADS, HEAD_DIM), cos, sin)
        v = v.reshape(b, s, N_KV_HEADS, HEAD_DIM)
        attn = sliding_window_sink_attention(q, k, v, attn_sinks[l])
        attn_out = jnp.einsum('bsc,cd->bsd', attn, w_attn_out[l])

        merged = jax.nn.sigmoid(gate_c) * conv_out + jax.nn.sigmoid(gate_a) * attn_out
        x = x + jnp.einsum('bsd,de->bse', merged, w_o[l])

        h = rms_norm(x, g_ffn[l])
        gu = jnp.einsum('bsd,df->bsf', h, w_gate_up[l])
        g_act, up = gu[..., :D_FF], gu[..., D_FF:]
        x = x + jnp.einsum('bsf,fd->bsd', jax.nn.silu(g_act) * up, w_down[l])
    return rms_norm(x, g_final)
```

```cpp
#include <hip/hip_runtime.h>
#include <hip/hip_cooperative_groups.h>
#include <cstdio>
#include <cstdint>
#include <cmath>
namespace cg = cooperative_groups;

#define LAS __attribute__((address_space(3)))
typedef unsigned short h16_t;
typedef _Float16 h16x8 __attribute__((ext_vector_type(8)));
typedef _Float16 h16x2 __attribute__((ext_vector_type(2)));
typedef float f32x4 __attribute__((ext_vector_type(4)));
typedef float f32x16 __attribute__((ext_vector_type(16)));
typedef unsigned u32x4 __attribute__((ext_vector_type(4)));
typedef unsigned u32x2 __attribute__((ext_vector_type(2)));

constexpr int D = 1024, BATCH = 8, SEQ = 2048, M = BATCH * SEQ;
constexpr int NH = 16, NKV = 4, HD = 64, DKV = NKV * HD;
constexpr int DFF = 2816, NIN = 6656;
constexpr float EPS = 1e-5f;
constexpr int NWAVES = 8, NTHREADS = 512;

constexpr size_t MiB = 1u << 20;
constexpr size_t WS_ROPE = 0;
constexpr size_t WS_RP1 = 256 * 1024;
constexpr size_t WS_RP2 = 512 * 1024;
constexpr size_t WS_WIN = 1 * MiB;
constexpr size_t WS_WC = 14 * MiB, WS_WA = 16 * MiB, WS_WO = 18 * MiB;
constexpr size_t WS_WGU = 20 * MiB;
constexpr size_t WS_WD = 31 * MiB;
constexpr size_t WS_H0 = 40 * MiB;
constexpr size_t WS_U = 72 * MiB;
constexpr size_t WS_CB = 104 * MiB;
constexpr size_t WS_Q = 136 * MiB;
constexpr size_t WS_K = 168 * MiB, WS_V = 176 * MiB;
constexpr size_t WS_GC = 184 * MiB;
constexpr size_t WS_GA = 216 * MiB;
constexpr size_t WS_ACT = 40 * MiB;
constexpr size_t WS_END = 248 * MiB;

constexpr size_t WS_BAR = 832 * 1024;
constexpr size_t WS_PCNT = WS_BAR + 16384;
constexpr size_t WS_R6 = WS_BAR + 32768, WS_R7 = WS_R6 + 256, WS_PB = WS_R6 + 1024, WS_RX = WS_PB + 16384;
constexpr size_t WS_GRP = WS_BAR + 57344;
constexpr int LDS_BAR_ST = 147456 - 16;
constexpr int LDS_BYTES = 147456;

__device__ __forceinline__ unsigned cvt_pk_h(float lo, float hi) { h16x2 v; v.x = (_Float16)lo; v.y = (_Float16)hi; return __builtin_bit_cast(unsigned, v); }
__device__ __forceinline__ float h_lo(unsigned w) { return (float)__builtin_bit_cast(h16x2, w).x; }
__device__ __forceinline__ float h_hi(unsigned w) { return (float)__builtin_bit_cast(h16x2, w).y; }
__device__ __forceinline__ float sigmoidf_(float x) { return __builtin_amdgcn_rcpf(1.0f + __builtin_amdgcn_exp2f(-1.4426950408889634f * x)); }
__device__ __forceinline__ float wave_sum(float v) {
#pragma unroll
    for (int o = 1; o < 64; o <<= 1) v += __shfl_xor(v, o);
    return v;
}
#define LDS_WAIT() asm volatile("s_waitcnt lgkmcnt(0)" ::: "memory")


#define SYNC_SPIN_CAP (1u << 22)
__device__ __forceinline__ unsigned xb_xcc_id() { return (unsigned)__builtin_amdgcn_s_getreg((3 << 11) | 20) & 0xFu; }
__device__ __forceinline__ void wave_arrive(unsigned* cnt, bool samex, int lane) {
    asm volatile("s_waitcnt vmcnt(0)" ::: "memory");
    if (lane == 0) {
        if (!samex) { __builtin_amdgcn_fence(__ATOMIC_RELEASE, "agent"); asm volatile("s_waitcnt vmcnt(0)" ::: "memory"); }
        __hip_atomic_fetch_add(cnt, 1u, __ATOMIC_RELAXED, __HIP_MEMORY_SCOPE_AGENT);
    }
}
__device__ __forceinline__ void block_wait(unsigned* cnt, unsigned target) {
    if (threadIdx.x == 0) {
        unsigned sp = 0;
        while (__hip_atomic_load(cnt, __ATOMIC_RELAXED, __HIP_MEMORY_SCOPE_AGENT) < target) { __builtin_amdgcn_s_sleep(2); if (++sp > SYNC_SPIN_CAP) break; }
        __builtin_amdgcn_fence(__ATOMIC_ACQUIRE, "agent");
        asm volatile("s_waitcnt vmcnt(0)" ::: "memory");
    }
    __syncthreads();
}
__device__ __forceinline__ void panel_barrier(unsigned* cnt, unsigned target, unsigned xcc) {
    asm volatile("s_waitcnt vmcnt(0)" ::: "memory");
    __syncthreads();
    if (threadIdx.x == 0) {
        __hip_atomic_fetch_or(cnt + 1, 1u << xcc, __ATOMIC_RELAXED, __HIP_MEMORY_SCOPE_AGENT);
        asm volatile("s_waitcnt vmcnt(0)" ::: "memory");
        __hip_atomic_fetch_add(cnt, 1u, __ATOMIC_RELAXED, __HIP_MEMORY_SCOPE_AGENT);
        unsigned sp = 0;
        while (__hip_atomic_load(cnt, __ATOMIC_RELAXED, __HIP_MEMORY_SCOPE_AGENT) < target) { __builtin_amdgcn_s_sleep(1); if (++sp > SYNC_SPIN_CAP) break; }
        const unsigned mask = __hip_atomic_load(cnt + 1, __ATOMIC_RELAXED, __HIP_MEMORY_SCOPE_AGENT);
        if (mask & (mask - 1u)) {
            __builtin_amdgcn_fence(__ATOMIC_RELEASE, "agent"); asm volatile("s_waitcnt vmcnt(0)" ::: "memory");
            __hip_atomic_fetch_add(cnt + 2, 1u, __ATOMIC_RELAXED, __HIP_MEMORY_SCOPE_AGENT);
            sp = 0;
            while (__hip_atomic_load(cnt + 2, __ATOMIC_RELAXED, __HIP_MEMORY_SCOPE_AGENT) < target) { __builtin_amdgcn_s_sleep(1); if (++sp > SYNC_SPIN_CAP) break; }
        }
        __builtin_amdgcn_fence(__ATOMIC_ACQUIRE, "agent");
        asm volatile("s_waitcnt vmcnt(0)" ::: "memory");
    }
    __syncthreads();
}

__host__ __device__ __forceinline__ size_t act_slot(int pm) {
    const int g = pm >> 3, l = pm & 7, p = l & 3;
    return ((size_t)(40 + 32 * p + 48 * ((p >> 1) & p)) + 4 * (size_t)g + 2 * (size_t)(l >> 2)) * MiB;
}

namespace pg8 {
constexpr int BM = 256, BK = 64, HALF = 128, HTB = HALF * BK * 2, STAGE_BYTES = 8 * HTB, NXCD = 8, WGM = 8;
__host__ __device__ __forceinline__ int lds_byte(int r, int c) { const int st = (r >> 4) * 2 + (c >> 5), rr = r & 15, cc = c & 31, ob = rr * 64 + cc * 2; return st * 1024 + (ob ^ (((ob >> 9) & 1) << 5)); }
__host__ __device__ __forceinline__ void stage_rc(int b, int& R, int& C) { const int st = b / 1024, sb = b % 1024, swz = sb ^ (((sb >> 9) & 1) << 5); R = (st >> 1) * 16 + swz / 64; C = (st & 1) * 32 + (swz % 64) / 2; }
__host__ __device__ __forceinline__ int perm32(int rho) { const int n = rho >> 4, i = rho & 15; return 8 * (i >> 2) + 4 * n + (i & 3); }

struct Unit { int pm, pn, z; long long aoff; };
struct Gemm { const h16_t* A0; const h16_t* B0; const h16_t* A1; const h16_t* B1; int K; };

struct StaticOrder {
    int nM, nN, nwg, G, c, act;
    __device__ void init(int M_, int N_, int G_, int c_, int act_ = 0) { nM = M_ / BM; nN = N_ / BM; nwg = nM * nN; G = G_; c = c_; act = act_; }
    __device__ bool next(int i, Unit& u) const {
        const long L = (long)i * G + c; if (L >= nwg) return false;
        int wgid = (int)L; { const int q = nwg / NXCD, r = nwg % NXCD, xcd = wgid % NXCD, off = wgid / NXCD; wgid = (xcd < r ? xcd * (q + 1) : r * (q + 1) + (xcd - r) * q) + off; }
        const int nig = WGM * nN, gid = wgid / nig, fm = gid * WGM, gsz = (nM - fm) < WGM ? (nM - fm) : WGM;
        u.pm = fm + ((wgid % nig) % gsz); u.pn = (wgid % nig) / gsz; u.z = 0; u.aoff = act ? (long long)act_slot(u.pm) : -1; return true;
    }
    __device__ __forceinline__ void done(int, int) const {}
};
struct DualOrder {
    StaticOrder so;
    __device__ bool next(int i, Unit& u) const { if (i >= 2) return false; if (!so.next(0, u)) return false; u.z = i; return true; }
    __device__ __forceinline__ void done(int, int) const {}
};
struct ProjOrder {
    int c; unsigned* r6; unsigned* r7; bool samex;
    __device__ bool next(int i, Unit& u) const {
        const int idx = 32 * i + (c >> 3); if (idx >= 208) return false;
        int pm, pn;
        if (idx < 176) { pm = idx & 7; pn = idx >> 3; } else if (idx < 192) { const int j = idx - 176; pm = j & 3; pn = 22 + (j >> 2); } else { const int j = idx - 192; pm = 4 + (j & 3); pn = 22 + (j >> 2); }
        u.pm = 8 * (c & 7) + pm; u.pn = pn; u.z = 0; u.aoff = -1; return true;
    }
    __device__ __forceinline__ void done(int ui, int lane) const { if (ui == 5) wave_arrive(r6, samex, lane); if (ui == 6) wave_arrive(r7, samex, lane); }
};
struct SwiOrder {
    int c; unsigned* l4; unsigned tgt;
    __device__ __forceinline__ bool next(int i, Unit& u) const {
        const int idx = 16 * i + ((c >> 3) & 15); int pm, pn;
        if (c >= 128) {
            if (idx >= 96) return false;
            if (idx < 88) { pm = idx & 3; pn = idx >> 2; }
            else { const int k = idx - 88; pm = 4 + (k & 3); pn = 20 + (k >> 2);
                unsigned sp = 0;
                while (__hip_atomic_load(l4, __ATOMIC_RELAXED, __HIP_MEMORY_SCOPE_AGENT) < tgt) { __builtin_amdgcn_s_sleep(2); if (++sp > SYNC_SPIN_CAP) break; }
                __builtin_amdgcn_fence(__ATOMIC_ACQUIRE, "agent"); }
        } else { if (idx >= 80) return false; pm = 4 + (idx & 3); pn = idx >> 2; }
        u.pm = 8 * (c & 7) + pm; u.pn = pn; u.z = 0; u.aoff = -1; return true;
    }
    __device__ __forceinline__ void done(int, int) const {}
};
__device__ __forceinline__ void panel_of(int c, int& pm, int& pn) { const int pj = (c >> 3) & 15; pm = 8 * (c & 7) + ((c < 128) ? 4 : 0) + (pj >> 2); pn = pj & 3; }
struct PanelDual {
    int c, n;
    __device__ bool next(int i, Unit& u) const { if (i >= n) return false; panel_of(c, u.pm, u.pn); u.z = i; u.aoff = -1; return true; }
    __device__ __forceinline__ void done(int, int) const {}
};
struct PanelOne {
    int c, n;
    __device__ bool next(int i, Unit& u) const { if (i >= n) return false; panel_of(c, u.pm, u.pn); u.z = 0; u.aoff = -1; return true; }
    __device__ __forceinline__ void done(int, int) const {}
};

template <class Epi, class Sched, bool ALIGN_EPI>
__device__ __forceinline__ void gemm_phase(LAS unsigned char* lds, const Gemm g, const Sched& S, const Epi& E) {
    const int tid = threadIdx.x, wid = __builtin_amdgcn_readfirstlane(tid >> 6), lane = tid & 63, wr = wid >> 2, wc = wid & 3, fr = lane & 15, fq = lane >> 4;
    const int K = g.K, nt = K / BK;
    unsigned voffA[2], voffB[2];
#pragma unroll
    for (int i = 0; i < 2; ++i) { int R, C; stage_rc(tid * 16 + i * 8192, R, C); const int Rb = (R & ~31) + perm32(R & 31);
        voffA[i] = (unsigned)(R * K + C) * 2u; voffB[i] = (unsigned)(Rb * K + C) * 2u; }
    const size_t kstep = (size_t)(BK * 2);
    const size_t hstep = (size_t)HALF * K * 2;
    const size_t tstep = 2 * hstep;
    const unsigned ldsw = (unsigned)wid * 1024u;
    const int aoff = lds_byte(wr * 64 + fr, fq * 8), boff = lds_byte(wc * 32 + fr, fq * 8);
#define PG8_SA(b, h) (((b) * 2 + (h)) * HTB)
#define PG8_SB(b, h) ((4 + (b) * 2 + (h)) * HTB)
#define PG8_STAGE(bufoff, gbase, voff) do { _Pragma("unroll") for (int _i = 0; _i < 2; ++_i) \
        __builtin_amdgcn_global_load_lds((const unsigned*)((const char*)(gbase) + (voff)[_i]), (LAS unsigned*)(lds + (bufoff) + ldsw + _i * 8192), 16, 0, 0); } while (0)
#define PG8_LDA(dst, b, h) do { _Pragma("unroll") for (int m = 0; m < 4; ++m) _Pragma("unroll") for (int k = 0; k < 2; ++k) dst[m][k] = *(const LAS h16x8*)(lds + PG8_SA(b, h) + aoff + m * 2048 + k * 1024); } while (0)
#define PG8_LDB(dst, b, h) do { _Pragma("unroll") for (int n = 0; n < 2; ++n) _Pragma("unroll") for (int k = 0; k < 2; ++k) dst[n][k] = *(const LAS h16x8*)(lds + PG8_SB(b, h) + boff + n * 2048 + k * 1024); } while (0)
#define PG8_MMA(ai, bj, At, Bt) do { __builtin_amdgcn_s_setprio(1); _Pragma("unroll") for (int m = 0; m < 4; ++m) _Pragma("unroll") for (int n = 0; n < 2; ++n) _Pragma("unroll") for (int k = 0; k < 2; ++k) \
        acc[ai][bj][m][n] = __builtin_amdgcn_mfma_f32_16x16x32_f16(Bt[n][k], At[m][k], acc[ai][bj][m][n], 0, 0, 0); __builtin_amdgcn_s_setprio(0); } while (0)
#define PG8_WAIT_V(n) asm volatile("s_waitcnt vmcnt(" #n ")" ::: "memory")
#define PG8_WAIT_L(n) asm volatile("s_waitcnt lgkmcnt(" #n ")" ::: "memory")
#define PG8_BAR __builtin_amdgcn_s_barrier()
#define PG8_SCHED __builtin_amdgcn_sched_barrier(0)
    Unit cur, nxt; int ui = 0;
    if (!S.next(0, cur)) return;
    f32x4 acc[2][2][4][2]; typename Epi::Tmp itmp;
    E.init_acc(acc, itmp, cur, wr, wc, fr, fq);
    h16x8 At[4][2], B0[2][2], B1[2][2];
    const char* cA = cur.aoff >= 0 ? (const char*)g.A0 + cur.aoff : (const char*)(cur.z ? g.A1 : g.A0) + (size_t)cur.pm * tstep; const char* cB = (const char*)(cur.z ? g.B1 : g.B0) + (size_t)cur.pn * tstep;
    PG8_STAGE(PG8_SB(0, 0), cB, voffB); PG8_STAGE(PG8_SB(0, 1), cB + hstep, voffB); PG8_STAGE(PG8_SA(0, 0), cA, voffA); PG8_STAGE(PG8_SA(0, 1), cA + hstep, voffA);
    if (wr == 1) PG8_BAR;
    PG8_WAIT_V(2); PG8_BAR;
    PG8_STAGE(PG8_SB(1, 0), cB + kstep, voffB); PG8_STAGE(PG8_SA(1, 0), cA + kstep, voffA); PG8_STAGE(PG8_SB(1, 1), cB + hstep + kstep, voffB);
    PG8_WAIT_V(6); PG8_BAR;
    E.finish_acc(acc, itmp);
    for (;;) {
        const bool has_next = S.next(ui + 1, nxt);
        const char* nA = has_next ? (nxt.aoff >= 0 ? (const char*)g.A0 + nxt.aoff : (const char*)(nxt.z ? g.A1 : g.A0) + (size_t)nxt.pm * tstep) : cA; const char* nB = has_next ? (const char*)(nxt.z ? g.B1 : g.B0) + (size_t)nxt.pn * tstep : cB;
        for (int t = 0; t < nt; t += 2) {
            const bool last = (t == nt - 2);
            const char* a1 = cA + (size_t)(t + 1) * kstep;
            const char* a2 = last ? nA : cA + (size_t)(t + 2) * kstep; const char* b2 = last ? nB : cB + (size_t)(t + 2) * kstep;
            const char* a3 = a2 + kstep; const char* b3 = b2 + kstep;
            PG8_LDB(B0, 0, 0); PG8_LDB(B1, 0, 1); PG8_SCHED; PG8_LDA(At, 0, 0); PG8_STAGE(PG8_SA(1, 1), a1 + hstep, voffA);
            PG8_WAIT_V(8); PG8_WAIT_L(0); PG8_BAR; PG8_MMA(0, 0, At, B0); PG8_MMA(0, 1, At, B1); PG8_BAR; PG8_SCHED;
            PG8_LDA(At, 0, 1); PG8_STAGE(PG8_SB(0, 0), b2, voffB); PG8_STAGE(PG8_SB(0, 1), b2 + hstep, voffB); PG8_STAGE(PG8_SA(0, 0), a2, voffA);
            PG8_WAIT_V(8); PG8_WAIT_L(0); PG8_BAR; PG8_MMA(1, 0, At, B0); PG8_MMA(1, 1, At, B1); PG8_BAR; PG8_SCHED;
            PG8_LDB(B0, 1, 0); PG8_LDB(B1, 1, 1); PG8_SCHED; PG8_LDA(At, 1, 0); PG8_STAGE(PG8_SA(0, 1), a2 + hstep, voffA);
            PG8_WAIT_V(8); PG8_WAIT_L(0); PG8_BAR; PG8_MMA(0, 0, At, B0); PG8_MMA(0, 1, At, B1); PG8_BAR; PG8_SCHED;
            PG8_LDA(At, 1, 1); PG8_STAGE(PG8_SB(1, 0), b3, voffB); PG8_STAGE(PG8_SB(1, 1), b3 + hstep, voffB); PG8_STAGE(PG8_SA(1, 0), a3, voffA);
            PG8_WAIT_V(8); PG8_WAIT_L(0); PG8_BAR; PG8_MMA(1, 0, At, B0); PG8_MMA(1, 1, At, B1); PG8_BAR; PG8_SCHED;
        }
        if constexpr (ALIGN_EPI) { if (wr == 0) PG8_BAR; }
        if constexpr (!Epi::AFTER_DRAIN) { E(acc, cur, wr, wc, fr, fq); S.done(ui, lane); }
        if (!has_next) break;
        if (!Epi::keep_acc(cur))
#pragma unroll
        for (int a = 0; a < 2; ++a)
#pragma unroll
            for (int b = 0; b < 2; ++b)
#pragma unroll
                for (int m = 0; m < 4; ++m)
#pragma unroll
                    for (int n = 0; n < 2; ++n) acc[a][b][m][n] = (f32x4){0.f, 0.f, 0.f, 0.f};
        cur = nxt; cA = nA; cB = nB; ++ui;
        if constexpr (ALIGN_EPI) { if (wr == 1) PG8_BAR; }
    }
    PG8_WAIT_V(0);
    if constexpr (!ALIGN_EPI) { if (wr == 0) PG8_BAR; }
    PG8_BAR;
    if constexpr (Epi::AFTER_DRAIN) { E.fused(acc, cur, wr, wc, fr, fq, lds, wid, lane); }
#undef PG8_SA
#undef PG8_SB
#undef PG8_STAGE
#undef PG8_LDA
#undef PG8_LDB
#undef PG8_MMA
#undef PG8_WAIT_V
#undef PG8_WAIT_L
#undef PG8_BAR
#undef PG8_SCHED
}

__device__ __forceinline__ u32x4 pack8(const f32x4 v0, const f32x4 v1) { u32x4 w; w.x = cvt_pk_h(v0[0], v0[1]); w.y = cvt_pk_h(v0[2], v0[3]); w.z = cvt_pk_h(v1[0], v1[1]); w.w = cvt_pk_h(v1[2], v1[3]); return w; }

struct EpiProj {
    static constexpr bool AFTER_DRAIN = false;
    struct Tmp {};
    __device__ __forceinline__ void init_acc(f32x4 (&acc)[2][2][4][2], Tmp&, const Unit&, int, int, int, int) const {
#pragma unroll
        for (int a = 0; a < 2; ++a)
#pragma unroll
            for (int b = 0; b < 2; ++b)
#pragma unroll
                for (int m = 0; m < 4; ++m)
#pragma unroll
                    for (int n = 0; n < 2; ++n) acc[a][b][m][n] = (f32x4){0.f, 0.f, 0.f, 0.f};
    }
    __device__ __forceinline__ void finish_acc(f32x4 (&)[2][2][4][2], Tmp&) const {}
    static __device__ __forceinline__ bool keep_acc(const Unit&) { return false; }
    h16_t *CB, *U, *Q, *Kb, *Vb, *GC, *GA;
    __device__ __forceinline__ void operator()(f32x4 (&acc)[2][2][4][2], const Unit& u, int wr, int wc, int fr, int fq) const {
        const int pn = u.pn, row0 = u.pm * BM + wr * 64 + fr;
        if (pn >= 4 && pn < 12) {
            const int col = 128 * (pn - 4) + 32 * wc + 8 * fq;
#pragma unroll
            for (int ai = 0; ai < 2; ++ai)
#pragma unroll
                for (int m = 0; m < 4; ++m) {
                    const f32x4 v0 = acc[ai][0][m][0] * acc[ai][1][m][0], v1 = acc[ai][0][m][1] * acc[ai][1][m][1];
                    *(u32x4*)(U + (size_t)(row0 + ai * HALF + m * 16) * D + col) = pack8(v0, v1);
                }
        } else if (pn >= 18) {
            const int col = 128 * (pn - 18) + 32 * wc + 8 * fq;
#pragma unroll
            for (int ai = 0; ai < 2; ++ai)
#pragma unroll
                for (int m = 0; m < 4; ++m) {
                    f32x4 r0, r1, a0, a1;
#pragma unroll
                    for (int e = 0; e < 4; ++e) { a0[e] = fmaxf(sigmoidf_(acc[ai][1][m][0][e]), 6.103515625e-5f); a1[e] = fmaxf(sigmoidf_(acc[ai][1][m][1][e]), 6.103515625e-5f); }
                    const u32x4 aw = pack8(a0, a1);
                    a0[0] = h_lo(aw.x); a0[1] = h_hi(aw.x); a0[2] = h_lo(aw.y); a0[3] = h_hi(aw.y); a1[0] = h_lo(aw.z); a1[1] = h_hi(aw.z); a1[2] = h_lo(aw.w); a1[3] = h_hi(aw.w);
#pragma unroll
                    for (int e = 0; e < 4; ++e) { r0[e] = sigmoidf_(acc[ai][0][m][0][e]) * __builtin_amdgcn_rcpf(a0[e]); r1[e] = sigmoidf_(acc[ai][0][m][1][e]) * __builtin_amdgcn_rcpf(a1[e]); }
                    const size_t off = (size_t)(row0 + ai * HALF + m * 16) * D + col;
                    *(u32x4*)(GC + off) = pack8(r0, r1);
                    *(u32x4*)(GA + off) = aw;
                }
        } else {
            h16_t* base; int ldc = D, colt; float sc = 1.f;
            if (pn < 4) { base = CB; colt = pn * 256; }
            else if (pn < 16) { base = Q; colt = (pn - 12) * 256; sc = 0.125f * 1.4426950408889634f; }
            else if (pn == 16) { base = Kb; colt = 0; ldc = DKV; }
            else { base = Vb; colt = 0; ldc = DKV; }
            const int col = colt + 32 * wc + 8 * fq;
#pragma unroll
            for (int ai = 0; ai < 2; ++ai)
#pragma unroll
                for (int m = 0; m < 4; ++m) { h16_t* rowp = base + (size_t)(row0 + ai * HALF + m * 16) * ldc + col;
#pragma unroll
                    for (int bj = 0; bj < 2; ++bj) { f32x4 v0 = acc[ai][bj][m][0], v1 = acc[ai][bj][m][1];
                        v0 = v0 * sc; v1 = v1 * sc;
                        *(u32x4*)(rowp + bj * HALF) = pack8(v0, v1); } }
        }
    }
};

struct EpiGated {
    static constexpr bool AFTER_DRAIN = false;
    struct Tmp {};
    __device__ __forceinline__ void init_acc(f32x4 (&acc)[2][2][4][2], Tmp&, const Unit&, int, int, int, int) const {
#pragma unroll
        for (int a = 0; a < 2; ++a)
#pragma unroll
            for (int b = 0; b < 2; ++b)
#pragma unroll
                for (int m = 0; m < 4; ++m)
#pragma unroll
                    for (int n = 0; n < 2; ++n) acc[a][b][m][n] = (f32x4){0.f, 0.f, 0.f, 0.f};
    }
    __device__ __forceinline__ void finish_acc(f32x4 (&)[2][2][4][2], Tmp&) const {}
    static __device__ __forceinline__ bool keep_acc(const Unit& u) { return u.z == 0; }
    const h16_t* R; h16_t* SA;
    __device__ __forceinline__ void operator()(f32x4 (&acc)[2][2][4][2], const Unit& u, int wr, int wc, int fr, int fq) const {
        const int row0 = u.pm * BM + wr * 64 + fr, col0 = u.pn * BM + 32 * wc + 8 * fq;
        if (u.z == 0) {
#pragma unroll
            for (int ai = 0; ai < 2; ++ai)
#pragma unroll
                for (int m = 0; m < 4; ++m)
#pragma unroll
                    for (int bj = 0; bj < 2; ++bj) {
                        const size_t off = (size_t)(row0 + ai * HALF + m * 16) * D + col0 + bj * HALF;
                        const u32x4 gw = *(const u32x4*)(R + off);
                        f32x4 v0 = acc[ai][bj][m][0], v1 = acc[ai][bj][m][1];
                        v0[0] *= h_lo(gw.x); v0[1] *= h_hi(gw.x); v0[2] *= h_lo(gw.y); v0[3] *= h_hi(gw.y);
                        v1[0] *= h_lo(gw.z); v1[1] *= h_hi(gw.z); v1[2] *= h_lo(gw.w); v1[3] *= h_hi(gw.w);
                        acc[ai][bj][m][0] = v0; acc[ai][bj][m][1] = v1;
                    }
        } else {
#pragma unroll
            for (int ai = 0; ai < 2; ++ai)
#pragma unroll
                for (int m = 0; m < 4; ++m)
#pragma unroll
                    for (int bj = 0; bj < 2; ++bj) {
                        const size_t off = (size_t)(row0 + ai * HALF + m * 16) * D + col0 + bj * HALF;
                        const u32x4 gw = *(const u32x4*)(SA + off);
                        f32x4 v0 = acc[ai][bj][m][0], v1 = acc[ai][bj][m][1];
                        v0[0] *= h_lo(gw.x); v0[1] *= h_hi(gw.x); v0[2] *= h_lo(gw.y); v0[3] *= h_hi(gw.y);
                        v1[0] *= h_lo(gw.z); v1[1] *= h_hi(gw.z); v1[2] *= h_lo(gw.w); v1[3] *= h_hi(gw.w);
                        *(u32x4*)(SA + off) = pack8(v0, v1);
                    }
        }
    }
};

struct EpiResid {
    static constexpr bool AFTER_DRAIN = true;
    struct Tmp {};
    __device__ __forceinline__ void init_acc(f32x4 (&acc)[2][2][4][2], Tmp&, const Unit& u, int wr, int wc, int fr, int fq) const {
        const int col0 = u.pn * BM + 32 * wc + 8 * fq;
#pragma unroll
        for (int ai = 0; ai < 2; ++ai)
#pragma unroll
            for (int m = 0; m < 4; ++m) { const size_t off = (size_t)(u.pm * BM + ai * HALF + wr * 64 + m * 16 + fr) * D + col0;
#pragma unroll
                for (int bj = 0; bj < 2; ++bj) { acc[ai][bj][m][0] = *(const f32x4*)(base + off + bj * HALF); acc[ai][bj][m][1] = *(const f32x4*)(base + off + bj * HALF + 4); } }
    }
    __device__ __forceinline__ void finish_acc(f32x4 (&)[2][2][4][2], Tmp&) const {}
    static __device__ __forceinline__ bool keep_acc(const Unit&) { return false; }
    const float* base; h16_t* xh; float* rowpart;
    __device__ __forceinline__ void fused(f32x4 (&acc)[2][2][4][2], const Unit& u, int wr, int wc, int fr, int fq, LAS unsigned char* lds, int wid, int lane) const {
        LAS float* P = (LAS float*)lds;
        const int col0 = u.pn * BM + 32 * wc + 8 * fq;
#pragma unroll
        for (int ai = 0; ai < 2; ++ai)
#pragma unroll
            for (int m = 0; m < 4; ++m) {
                const int rl = ai * HALF + wr * 64 + m * 16 + fr; const size_t off = (size_t)(u.pm * BM + rl) * D + col0;
                float ss = 0.f;
#pragma unroll
                for (int bj = 0; bj < 2; ++bj) {
                    const f32x4 v0 = acc[ai][bj][m][0], v1 = acc[ai][bj][m][1];
                    *(u32x4*)(xh + off + bj * HALF) = pack8(v0, v1);
                    ss += (v0[0] * v0[0] + v0[1] * v0[1]) + (v0[2] * v0[2] + v0[3] * v0[3]) + (v1[0] * v1[0] + v1[1] * v1[1]) + (v1[2] * v1[2] + v1[3] * v1[3]);
                }
                ss += __shfl_xor(ss, 16); ss += __shfl_xor(ss, 32);
                if (fq == 0) P[rl * 4 + wc] = ss;
            }
        __syncthreads();
        const int tid = wid * 64 + lane;
        if (tid < 256) { const f32x4 p = *(const LAS f32x4*)(P + tid * 4); rowpart[(size_t)(u.pm * BM + tid) * 4 + u.pn] = (p[0] + p[1]) + (p[2] + p[3]); }
    }
};

struct EpiSwiGLU {
    static constexpr bool AFTER_DRAIN = false;
    struct Tmp {};
    __device__ __forceinline__ void init_acc(f32x4 (&acc)[2][2][4][2], Tmp&, const Unit&, int, int, int, int) const {
#pragma unroll
        for (int a = 0; a < 2; ++a)
#pragma unroll
            for (int b = 0; b < 2; ++b)
#pragma unroll
                for (int m = 0; m < 4; ++m)
#pragma unroll
                    for (int n = 0; n < 2; ++n) acc[a][b][m][n] = (f32x4){0.f, 0.f, 0.f, 0.f};
    }
    __device__ __forceinline__ void finish_acc(f32x4 (&)[2][2][4][2], Tmp&) const {}
    static __device__ __forceinline__ bool keep_acc(const Unit&) { return false; }
    unsigned char* wsb; const float* rowpart;
    __device__ __forceinline__ void operator()(f32x4 (&acc)[2][2][4][2], const Unit& u, int wr, int wc, int fr, int fq) const {
        const int row0 = u.pm * BM + wr * 64 + fr, col = 128 * u.pn + 32 * wc + 8 * fq;
        h16_t* ACT = (h16_t*)(wsb + act_slot(u.pm)) - (size_t)(u.pm * BM) * DFF;
#pragma unroll
        for (int ai = 0; ai < 2; ++ai)
#pragma unroll
            for (int m = 0; m < 4; ++m) {
                const int row = row0 + ai * HALF + m * 16;
                const f32x4 p = *(const f32x4*)(rowpart + (size_t)row * 4);
                const float rs = 1.0f / sqrtf(((p[0] + p[1]) + (p[2] + p[3])) * (1.0f / D) + EPS);
                f32x4 o[2];
#pragma unroll
                for (int n = 0; n < 2; ++n)
#pragma unroll
                    for (int e = 0; e < 4; ++e) { const float gv = acc[ai][0][m][n][e] * rs, uv = acc[ai][1][m][n][e] * rs; o[n][e] = gv * sigmoidf_(gv) * uv; }
                *(u32x4*)(ACT + (size_t)row * DFF + col) = pack8(o[0], o[1]);
            }
    }
};

struct EpiFinal {
    static constexpr bool AFTER_DRAIN = true;
    struct Tmp { u32x4 w[2][4][2]; };
    __device__ __forceinline__ void init_acc(f32x4 (&)[2][2][4][2], Tmp& t, const Unit& u, int wr, int wc, int fr, int fq) const {
        const int col0 = u.pn * BM + 32 * wc + 8 * fq;
#pragma unroll
        for (int ai = 0; ai < 2; ++ai)
#pragma unroll
            for (int m = 0; m < 4; ++m) { const size_t off = (size_t)(u.pm * BM + ai * HALF + wr * 64 + m * 16 + fr) * D + col0;
#pragma unroll
                for (int bj = 0; bj < 2; ++bj) t.w[ai][m][bj] = *(const u32x4*)(xh + off + bj * HALF); }
    }
    __device__ __forceinline__ void finish_acc(f32x4 (&acc)[2][2][4][2], Tmp& t) const {
#pragma unroll
        for (int ai = 0; ai < 2; ++ai)
#pragma unroll
            for (int m = 0; m < 4; ++m)
#pragma unroll
                for (int bj = 0; bj < 2; ++bj) { const u32x4 hw = t.w[ai][m][bj];
                    acc[ai][bj][m][0] = (f32x4){h_lo(hw.x), h_hi(hw.x), h_lo(hw.y), h_hi(hw.y)}; acc[ai][bj][m][1] = (f32x4){h_lo(hw.z), h_hi(hw.z), h_lo(hw.w), h_hi(hw.w)}; }
    }
    static __device__ __forceinline__ bool keep_acc(const Unit&) { return false; }
    const h16_t* xh; float* out; const float* gfin; float* slots; unsigned* cnt;
    __device__ __forceinline__ void fused(f32x4 (&acc)[2][2][4][2], const Unit& u, int wr, int wc, int fr, int fq, LAS unsigned char* lds, int wid, int lane) const {
        LAS float* P = (LAS float*)lds;
        LAS float* S = (LAS float*)(lds + 4096);
        const int col0 = u.pn * BM + 32 * wc + 8 * fq;
#pragma unroll
        for (int ai = 0; ai < 2; ++ai)
#pragma unroll
            for (int m = 0; m < 4; ++m) {
                const int rl = ai * HALF + wr * 64 + m * 16 + fr; const size_t off = (size_t)(u.pm * BM + rl) * D + col0;
                float ss = 0.f;
#pragma unroll
                for (int bj = 0; bj < 2; ++bj) {
                    const f32x4 v0 = acc[ai][bj][m][0], v1 = acc[ai][bj][m][1];
                    ss += (v0[0] * v0[0] + v0[1] * v0[1]) + (v0[2] * v0[2] + v0[3] * v0[3]) + (v1[0] * v1[0] + v1[1] * v1[1]) + (v1[2] * v1[2] + v1[3] * v1[3]);
                }
                ss += __shfl_xor(ss, 16); ss += __shfl_xor(ss, 32);
                if (fq == 0) P[rl * 4 + wc] = ss;
            }
        __syncthreads();
        const int tid = wid * 64 + lane;
        if (tid < 256) { const f32x4 p = *(const LAS f32x4*)(P + tid * 4);
            __hip_atomic_store(slots + (size_t)(u.pm * BM + tid) * 4 + u.pn, (p[0] + p[1]) + (p[2] + p[3]), __ATOMIC_RELAXED, __HIP_MEMORY_SCOPE_AGENT); }
        asm volatile("s_waitcnt vmcnt(0)" ::: "memory");
        if (tid < 256 && lane == 0) __hip_atomic_fetch_add(cnt + 64 * u.pm, 1u, __ATOMIC_RELAXED, __HIP_MEMORY_SCOPE_AGENT);
        if (wid == 0) {
            unsigned sp = 0;
            while ((unsigned)__builtin_amdgcn_readfirstlane(__hip_atomic_load(cnt + 64 * u.pm, __ATOMIC_RELAXED, __HIP_MEMORY_SCOPE_AGENT)) < 16u) { __builtin_amdgcn_s_sleep(1); if (++sp > (1u << 22)) break; }
            __builtin_amdgcn_fence(__ATOMIC_ACQUIRE, "agent");
        }
        asm volatile("s_waitcnt vmcnt(0) lgkmcnt(0)" ::: "memory");
        __syncthreads();
        if (tid < 256) { const float* sl = slots + (size_t)(u.pm * BM + tid) * 4; float t = 0.f;
#pragma unroll
            for (int q = 0; q < 4; ++q) t += __hip_atomic_load(sl + q, __ATOMIC_RELAXED, __HIP_MEMORY_SCOPE_AGENT);
            S[tid] = 1.0f / sqrtf(t * (1.0f / D) + EPS); }
        __syncthreads();
        f32x4 gv[2][2];
#pragma unroll
        for (int bj = 0; bj < 2; ++bj) { gv[bj][0] = *(const f32x4*)(gfin + col0 + bj * HALF); gv[bj][1] = *(const f32x4*)(gfin + col0 + bj * HALF + 4); }
#pragma unroll
        for (int ai = 0; ai < 2; ++ai)
#pragma unroll
            for (int m = 0; m < 4; ++m) {
                const int rl = ai * HALF + wr * 64 + m * 16 + fr; const size_t off = (size_t)(u.pm * BM + rl) * D + col0; const float rs = S[rl];
#pragma unroll
                for (int bj = 0; bj < 2; ++bj) { *(f32x4*)(out + off + bj * HALF) = acc[ai][bj][m][0] * rs * gv[bj][0]; *(f32x4*)(out + off + bj * HALF + 4) = acc[ai][bj][m][1] * rs * gv[bj][1]; }
            }
    }
};
}

__device__ __forceinline__ void p0_transpose_item(const float* W, int K, int N, h16_t* WT, int dst_row0, int n0, int k0, const float* kscale, LAS unsigned* scr, int lane) {
    const int nq = lane & 7, kq = lane >> 3;
    f32x4 ra[4], rb[4];
#pragma unroll
    for (int t = 0; t < 4; ++t) { const int kp = kq + 8 * t; const float* p = W + (size_t)(k0 + 2 * kp) * N + n0 + 4 * nq; ra[t] = __builtin_nontemporal_load((const f32x4*)p); rb[t] = __builtin_nontemporal_load((const f32x4*)(p + N)); }
#pragma unroll
    for (int t = 0; t < 4; ++t) { const int kp = kq + 8 * t; float s0 = 1.f, s1 = 1.f; if (kscale) { s0 = kscale[k0 + 2 * kp]; s1 = kscale[k0 + 2 * kp + 1]; }
#pragma unroll
        for (int i = 0; i < 4; ++i) scr[(4 * nq + i) * 33 + kp] = cvt_pk_h(ra[t][i] * s0, rb[t][i] * s1); }
    LDS_WAIT(); asm volatile("" ::: "memory");
    const int c = lane & 7;
#pragma unroll
    for (int j = 0; j < 4; ++j) { const int n = (lane >> 3) + 8 * j; const LAS unsigned* sp = scr + n * 33 + 4 * c;
        u32x4 o; o.x = sp[0]; o.y = sp[1]; o.z = sp[2]; o.w = sp[3];
        *(u32x4*)(WT + (size_t)(dst_row0 + n) * K + k0 + 8 * c) = o; }
    LDS_WAIT(); asm volatile("" ::: "memory");
}
__device__ __forceinline__ int map_win(int n) {
    if (n < 1024 || (n >= 3072 && n < 4608)) return n;
    if (n >= 4608) { const int c = (n - 4608) & 1023, isa = (n >= 5632) ? 1 : 0; return 4608 + 256 * (c >> 7) + 128 * isa + (c & 127); }
    const int c = (n - 1024) & 1023, isx = (n >= 2048) ? 1 : 0;
    return 1024 + 256 * (c >> 7) + 128 * isx + (c & 127);
}
__device__ __forceinline__ int map_wgu(int n) {
    const int isu = (n >= DFF) ? 1 : 0, c = n - isu * DFF;
    return 256 * (c >> 7) + 128 * isu + (c & 127);
}

constexpr int KS_STRIDE = 72, VT_STRIDE = 264;
constexpr int LDS_KS = 0, LDS_VT = 256 * KS_STRIDE * 2;

constexpr int ATT_UNIT_LDS = 70656;
struct QRaw { u32x4 a0, a1; h16x8 q1, q2, q3; f32x4 c0, c1, s0, s1; };
__device__ __forceinline__ void attn_qload(QRaw& r, const h16_t* qp, const float* ropep, int hi) {
    r.a0 = *(const u32x4*)qp; r.a1 = *(const u32x4*)(qp + 8);
    r.q1 = *(const h16x8*)(qp + 16 + 8 * hi); r.q2 = *(const h16x8*)(qp + 32 + 8 * hi); r.q3 = *(const h16x8*)(qp + 48 + 8 * hi);
    const f32x4* cs = (const f32x4*)ropep; r.c0 = cs[0]; r.c1 = cs[1]; r.s0 = cs[2]; r.s1 = cs[3];
}
__device__ __forceinline__ void attn_pair(LAS unsigned char* lds, int un0, h16_t* QO, const h16_t* Kb, const h16_t* Vb, const float* rope, const float* sinks) {
    const int tid = threadIdx.x, lane = tid & 63, wid = __builtin_amdgcn_readfirstlane(tid >> 6);
    const int qi = lane & 31, hi = lane >> 5;
    QRaw qc;
    {
        const int blk = un0 & 15, kvh = (un0 >> 4) & 3, b = un0 >> 6, head = kvh * 4 + (wid >> 1);
        const int qpos = blk * 128 + ((wid & 1) * 2) * 32 + qi;
        attn_qload(qc, QO + ((size_t)b * SEQ + qpos) * D + head * HD, rope + (size_t)qpos * 16, hi);
    }
    {
        const int kk = tid >> 1, half = tid & 1;
        u32x4 kv[2][4], vv[2][4]; f32x4 cs[2][4];
#pragma unroll
        for (int uu = 0; uu < 2; ++uu) {
            const int un = un0 + uu, blk = un & 15, kvh = (un >> 4) & 3, b = un >> 6;
            const int pos = blk * 128 - 128 + kk;
#pragma unroll
            for (int i = 0; i < 4; ++i) { kv[uu][i] = (u32x4){0u, 0u, 0u, 0u}; vv[uu][i] = (u32x4){0u, 0u, 0u, 0u}; cs[uu][i] = (f32x4){0.f, 0.f, 0.f, 0.f}; }
            if (pos >= 0) {
                const size_t row = (size_t)b * SEQ + pos;
                const u32x4* kp = (const u32x4*)(Kb + row * DKV + kvh * HD + half * 32);
                const u32x4* vp = (const u32x4*)(Vb + row * DKV + kvh * HD + half * 32);
#pragma unroll
                for (int i = 0; i < 4; ++i) { kv[uu][i] = kp[i]; vv[uu][i] = vp[i]; }
                if (half == 0) { const f32x4* cp = (const f32x4*)(rope + (size_t)pos * 16);
#pragma unroll
                    for (int i = 0; i < 4; ++i) cs[uu][i] = cp[i]; }
            }
        }
#pragma unroll
        for (int uu = 0; uu < 2; ++uu) {
            LAS h16_t* Ks = (LAS h16_t*)(lds + uu * ATT_UNIT_LDS + LDS_KS);
            LAS h16_t* VT = (LAS h16_t*)(lds + uu * ATT_UNIT_LDS + LDS_VT);
            if (half == 0) {
                float r1[8], r2[8], o1[8], o2[8];
#pragma unroll
                for (int e = 0; e < 4; ++e) { r1[2 * e] = h_lo(kv[uu][0][e]); r1[2 * e + 1] = h_hi(kv[uu][0][e]); r2[2 * e] = h_lo(kv[uu][1][e]); r2[2 * e + 1] = h_hi(kv[uu][1][e]); }
#pragma unroll
                for (int e = 0; e < 8; ++e) { const float c = e < 4 ? cs[uu][0][e & 3] : cs[uu][1][e & 3], sn = e < 4 ? cs[uu][2][e & 3] : cs[uu][3][e & 3]; o1[e] = r1[e] * c - r2[e] * sn; o2[e] = r2[e] * c + r1[e] * sn; }
#pragma unroll
                for (int e = 0; e < 4; ++e) { kv[uu][0][e] = cvt_pk_h(o1[2 * e], o1[2 * e + 1]); kv[uu][1][e] = cvt_pk_h(o2[2 * e], o2[2 * e + 1]); }
            }
#pragma unroll
            for (int i = 0; i < 4; ++i) *(LAS u32x4*)(Ks + kk * KS_STRIDE + half * 32 + 8 * i) = kv[uu][i];
#pragma unroll
            for (int i = 0; i < 4; ++i)
#pragma unroll
                for (int e = 0; e < 4; ++e) {
                    const int d = half * 32 + 8 * i + 2 * e;
                    VT[d * VT_STRIDE + kk] = (h16_t)(vv[uu][i][e] & 0xffffu);
                    VT[(d + 1) * VT_STRIDE + kk] = (h16_t)(vv[uu][i][e] >> 16);
                }
        }
    }
    __syncthreads();
    const int pk = (qi & 3) | (((qi >> 3) & 1) << 2) | (((qi >> 2) & 1) << 3) | (qi & 16);
#pragma unroll 1
    for (int st = 0; st < 4; ++st) {
        const int un = un0 + (st >> 1), blk = un & 15, kvh = (un >> 4) & 3, b = un >> 6, head = kvh * 4 + (wid >> 1);
        const int q0 = ((wid & 1) * 2 + (st & 1)) * 32;
        const int qpos = blk * 128 + q0 + qi;
        h16_t* qp = QO + ((size_t)b * SEQ + qpos) * D + head * HD;
        const float sink = sinks[head];
        LAS h16_t* Ks = (LAS h16_t*)(lds + (st >> 1) * ATT_UNIT_LDS + LDS_KS);
        LAS h16_t* VT = (LAS h16_t*)(lds + (st >> 1) * ATT_UNIT_LDS + LDS_VT);
        QRaw qn;
        {
            const int sn = st < 3 ? st + 1 : st;
            const int un_n = un0 + (sn >> 1), blk_n = un_n & 15, kvh_n = (un_n >> 4) & 3, b_n = un_n >> 6, head_n = kvh_n * 4 + (wid >> 1);
            const int qpos_n = blk_n * 128 + ((wid & 1) * 2 + (sn & 1)) * 32 + qi;
            attn_qload(qn, QO + ((size_t)b_n * SEQ + qpos_n) * D + head_n * HD, rope + (size_t)qpos_n * 16, hi);
        }
        h16x8 qf[4];
        {
            float r1[8], r2[8], o[8];
#pragma unroll
            for (int e = 0; e < 4; ++e) { r1[2 * e] = h_lo(qc.a0[e]); r1[2 * e + 1] = h_hi(qc.a0[e]); r2[2 * e] = h_lo(qc.a1[e]); r2[2 * e + 1] = h_hi(qc.a1[e]); }
#pragma unroll
            for (int e = 0; e < 8; ++e) { const float c = e < 4 ? qc.c0[e & 3] : qc.c1[e & 3], sn = e < 4 ? qc.s0[e & 3] : qc.s1[e & 3];
                o[e] = hi ? (r2[e] * c + r1[e] * sn) : (r1[e] * c - r2[e] * sn); }
            u32x4 w;
#pragma unroll
            for (int e = 0; e < 4; ++e) w[e] = cvt_pk_h(o[2 * e], o[2 * e + 1]);
            qf[0] = __builtin_bit_cast(h16x8, w); qf[1] = qc.q1; qf[2] = qc.q2; qf[3] = qc.q3;
        }
        f32x16 s[5];
#pragma unroll
        for (int j = 0; j < 5; ++j) {
            s[j] = (f32x16){0.f, 0.f, 0.f, 0.f, 0.f, 0.f, 0.f, 0.f, 0.f, 0.f, 0.f, 0.f, 0.f, 0.f, 0.f, 0.f};
#pragma unroll
            for (int ks = 0; ks < 4; ++ks) {
                const h16x8 kf = *(const LAS h16x8*)(Ks + (q0 + 32 * j + pk) * KS_STRIDE + 16 * ks + 8 * hi);
                s[j] = __builtin_amdgcn_mfma_f32_32x32x16_f16(kf, qf[ks], s[j], 0, 0, 0);
            }
        }
        const float NEG = -1e30f;
        const float sinkl = sink * 1.4426950408889634f;
        if (blk == 0) {
#pragma unroll
            for (int j = 0; j < 4; ++j) if (j < 4 - (q0 >> 5)) {
#pragma unroll
                for (int r = 0; r < 16; ++r) s[j][r] = NEG; }
        }
#pragma unroll
        for (int r = 0; r < 16; ++r) { const int kl = (r & 7) + 8 * hi + 16 * (r >> 3); s[0][r] = (kl > qi) ? s[0][r] : NEG; s[4][r] = (kl <= qi) ? s[4][r] : NEG; }
        float mx = sinkl;
#pragma unroll
        for (int j = 0; j < 5; ++j)
#pragma unroll
            for (int r = 0; r < 16; ++r) mx = fmaxf(mx, s[j][r]);
        mx = fmaxf(mx, __shfl_xor(mx, 32));
        float sum = 0.f;
#pragma unroll
        for (int j = 0; j < 5; ++j)
#pragma unroll
            for (int r = 0; r < 16; ++r) { const float p = __builtin_amdgcn_exp2f(s[j][r] - mx); s[j][r] = p; sum += p; }
        sum += __shfl_xor(sum, 32);
        sum += __builtin_amdgcn_exp2f(sinkl - mx);
        const float inv = 1.0f / sum;
        f32x16 o[2];
        o[0] = (f32x16){0.f, 0.f, 0.f, 0.f, 0.f, 0.f, 0.f, 0.f, 0.f, 0.f, 0.f, 0.f, 0.f, 0.f, 0.f, 0.f}; o[1] = o[0];
#pragma unroll
        for (int j = 0; j < 5; ++j)
#pragma unroll
            for (int h = 0; h < 2; ++h) {
                u32x4 w;
#pragma unroll
                for (int e = 0; e < 4; ++e) w[e] = cvt_pk_h(s[j][8 * h + 2 * e], s[j][8 * h + 2 * e + 1]);
                const h16x8 pf = __builtin_bit_cast(h16x8, w);
#pragma unroll
                for (int dt = 0; dt < 2; ++dt) {
                    const h16x8 vf = *(const LAS h16x8*)(VT + (dt * 32 + qi) * VT_STRIDE + q0 + 32 * j + 16 * h + 8 * hi);
                    o[dt] = __builtin_amdgcn_mfma_f32_32x32x16_f16(vf, pf, o[dt], 0, 0, 0);
                }
            }
#pragma unroll
        for (int dt = 0; dt < 2; ++dt)
#pragma unroll
            for (int r = 0; r < 16; ++r) o[dt][r] *= inv;
#pragma unroll
        for (int dt = 0; dt < 2; ++dt)
#pragma unroll
            for (int g4 = 0; g4 < 4; ++g4) {
                u32x2 w; w.x = cvt_pk_h(o[dt][4 * g4], o[dt][4 * g4 + 1]); w.y = cvt_pk_h(o[dt][4 * g4 + 2], o[dt][4 * g4 + 3]);
                *(u32x2*)(qp + 32 * dt + 8 * g4 + 4 * hi) = w;
            }
        qc = qn;
    }
    __syncthreads();
}

__device__ __forceinline__ void conv_item(int it, const h16_t* U, h16_t* CB, const float* cw) {
    const int tid = threadIdx.x, tc = tid >> 7, cgp = tid & 127;
    const int t0 = 64 * it + 16 * tc, c0 = 8 * cgp;
    u32x4 uw[18], bw[16];
    const bool first = (t0 & (SEQ - 1)) == 0;
    uw[0] = (u32x4){0u, 0u, 0u, 0u}; uw[1] = uw[0];
    if (!first) { uw[0] = *(const u32x4*)(U + (size_t)(t0 - 2) * D + c0); uw[1] = *(const u32x4*)(U + (size_t)(t0 - 1) * D + c0); }
#pragma unroll
    for (int i = 0; i < 16; ++i) { const size_t off = (size_t)(t0 + i) * D + c0; uw[i + 2] = *(const u32x4*)(U + off); bw[i] = *(const u32x4*)(CB + off); }
    float w0[8], w1[8], w2[8];
#pragma unroll
    for (int h = 0; h < 2; ++h) { const f32x4 a = *(const f32x4*)(cw + c0 + 4 * h), bq = *(const f32x4*)(cw + D + c0 + 4 * h), c = *(const f32x4*)(cw + 2 * D + c0 + 4 * h);
#pragma unroll
        for (int e = 0; e < 4; ++e) { w0[4 * h + e] = a[e]; w1[4 * h + e] = bq[e]; w2[4 * h + e] = c[e]; } }
#pragma unroll
    for (int i = 0; i < 16; ++i) {
        u32x4 o;
#pragma unroll
        for (int e = 0; e < 4; ++e) {
            const float ylo = h_lo(bw[i][e]) * (w0[2 * e] * h_lo(uw[i][e]) + w1[2 * e] * h_lo(uw[i + 1][e]) + w2[2 * e] * h_lo(uw[i + 2][e]));
            const float yhi = h_hi(bw[i][e]) * (w0[2 * e + 1] * h_hi(uw[i][e]) + w1[2 * e + 1] * h_hi(uw[i + 1][e]) + w2[2 * e + 1] * h_hi(uw[i + 2][e]));
            o[e] = cvt_pk_h(ylo, yhi);
        }
        *(u32x4*)(CB + (size_t)(t0 + i) * D + c0) = o;
    }
}

#define XB_TMO      128
#define XB_XCNT(j)  (256  + 64 * (j))
#define XB_XSUB(j)  (1280 + 64 * (j))
#define XB_XGEN(j)  (2304 + 64 * (j))
#define XB_TOP      3328
#define XB_TOPGEN   3392
#define XCD_BAR_WORDS 3456
#define XB_SPIN_CAP (1u << 18)
__device__ __forceinline__ unsigned xb_ld(unsigned* p)              { return __hip_atomic_load(p, __ATOMIC_RELAXED, __HIP_MEMORY_SCOPE_AGENT); }
__device__ __forceinline__ unsigned xb_add(unsigned* p, unsigned v) { return __hip_atomic_fetch_add(p, v, __ATOMIC_RELAXED, __HIP_MEMORY_SCOPE_AGENT); }
#define XB_SPIN(cond, bar) do { unsigned _sp = 0; while (cond) { __builtin_amdgcn_s_sleep(1); \
    if ((++_sp & 255u) == 0u) { if (xb_ld(&(bar)[XB_TMO])) break; if (_sp > XB_SPIN_CAP) { atomicAdd(&(bar)[XB_TMO], 1u); break; } } } } while (0)
struct XcdBarrier { unsigned* bar; unsigned x; volatile LAS unsigned* st; };
__device__ __forceinline__ XcdBarrier xcd_barrier_post(unsigned* bar, volatile LAS unsigned* st) {
    XcdBarrier b; b.bar = bar; b.x = xb_xcc_id(); b.st = st;
    if (threadIdx.x == 0) (void)xb_add(&bar[XB_XCNT(b.x)], 1u);
    return b;
}
__device__ __forceinline__ void xcd_barrier_complete(unsigned* bar, unsigned x, unsigned& nloc, unsigned& nx) {
    const unsigned G = gridDim.x * gridDim.y * gridDim.z;
    unsigned sum, cnt, mine, sp = 0u;
    for (;;) {
        sum = 0u; cnt = 0u; mine = 0u;
#pragma unroll
        for (unsigned j = 0; j < 16; ++j) { const unsigned c = xb_ld(&bar[XB_XCNT(j)]); sum += c; cnt += (c > 0u) ? 1u : 0u; mine = (j == x) ? c : mine; }
        if (sum == G) break;
        __builtin_amdgcn_s_sleep(1);
        if ((++sp & 255u) == 0u) { if (xb_ld(&bar[XB_TMO])) break; if (sp > XB_SPIN_CAP) { atomicAdd(&bar[XB_TMO], 1u); break; } }
    }
    nloc = mine > 0u ? mine : 1u; nx = cnt > 0u ? cnt : 1u;
}
__device__ __forceinline__ void xcd_barrier(const XcdBarrier& b) {
    asm volatile("s_waitcnt vmcnt(0)" ::: "memory");
    __syncthreads();
    if (threadIdx.x == 0) {
        unsigned* bar = b.bar;
        __builtin_amdgcn_s_waitcnt(0);
        unsigned nloc = b.st[0], nx = b.st[1];
        if (nloc == 0u) { xcd_barrier_complete(bar, b.x, nloc, nx); b.st[0] = nloc; b.st[1] = nx; }
        const unsigned old = xb_add(&bar[XB_XSUB(b.x)], 1u);
        const unsigned gen = old / nloc;
        if (old + 1u == (gen + 1u) * nloc) {
            __builtin_amdgcn_fence(__ATOMIC_RELEASE, "agent");
            asm volatile("s_waitcnt vmcnt(0)" ::: "memory");
            const unsigned og = xb_add(&bar[XB_TOP], 1u);
            const unsigned tg = og / nx;
            if (og + 1u == (tg + 1u) * nx) xb_add(&bar[XB_TOPGEN], 1u);
            else XB_SPIN(xb_ld(&bar[XB_TOPGEN]) == tg, bar);
            __builtin_amdgcn_fence(__ATOMIC_ACQUIRE, "agent");
            xb_add(&bar[XB_XGEN(b.x)], 1u);
            asm volatile("s_waitcnt vmcnt(0)" ::: "memory");
        } else {
            XB_SPIN(xb_ld(&bar[XB_XGEN(b.x)]) == gen, bar);
            __builtin_amdgcn_fence(__ATOMIC_ACQUIRE, "agent");
            asm volatile("s_waitcnt vmcnt(0)" ::: "memory");
        }
    }
    __syncthreads();
}

struct Args { const float* in[12]; float* out; unsigned char* ws; float inv_freq[8]; };

template <int PH> __device__ __forceinline__ void run_phase(const Args& a, LAS unsigned char* lds) {
    const int tid = threadIdx.x, lane = tid & 63, wave = __builtin_amdgcn_readfirstlane(tid >> 6);
    const int G = gridDim.x, bx = blockIdx.x;
    const int vcu = (G % 8 == 0) ? (bx % 8) * (G / 8) + bx / 8 : bx;
    unsigned char* ws = a.ws;
    const float* x = a.in[0]; const float* g_mix = a.in[1]; const float* w_in = a.in[2]; const float* conv_w = a.in[3]; const float* sinks = a.in[4];
    const float* w_conv_out = a.in[5]; const float* w_attn_out = a.in[6]; const float* w_o = a.in[7]; const float* g_ffn = a.in[8];
    const float* w_gate_up = a.in[9]; const float* w_down = a.in[10]; const float* g_final = a.in[11];
    float* rope = (float*)(ws + WS_ROPE); float* rp1 = (float*)(ws + WS_RP1); float* rp2 = (float*)(ws + WS_RP2);
    h16_t* Win_t = (h16_t*)(ws + WS_WIN); h16_t* Wc_t = (h16_t*)(ws + WS_WC); h16_t* Wa_t = (h16_t*)(ws + WS_WA); h16_t* Wo_t = (h16_t*)(ws + WS_WO);
    h16_t* Wgu_t = (h16_t*)(ws + WS_WGU); h16_t* Wd_t = (h16_t*)(ws + WS_WD);
    h16_t* H0 = (h16_t*)(ws + WS_H0); h16_t* Ub = (h16_t*)(ws + WS_U); h16_t* CBb = (h16_t*)(ws + WS_CB); h16_t* Qb = (h16_t*)(ws + WS_Q);
    h16_t* Kb = (h16_t*)(ws + WS_K); h16_t* Vb = (h16_t*)(ws + WS_V); h16_t* GCb = (h16_t*)(ws + WS_GC); h16_t* GAb = (h16_t*)(ws + WS_GA);
    h16_t* ACTb = (h16_t*)(ws + WS_ACT); h16_t* X1B = Qb;
    float* out = a.out;

    if constexpr (PH == 0) {
        LAS unsigned* scr = (LAS unsigned*)(lds + wave * 16384);
        const int gw = vcu * NWAVES + wave, NGW = G * NWAVES;
        constexpr int I_IN = (D / 64) * (NIN / 32);
        constexpr int I_SQ0 = (D / 64) * (D / 32);
        constexpr int I_GU0 = (D / 64) * (2 * DFF / 32), I_DN0 = (DFF / 64) * (D / 32);
        for (int it = gw; it < I_IN + 3 * I_SQ0 + I_GU0 + I_DN0; it += NGW) {
            int r = it;
            if (r < I_IN) { const int nb = r % (NIN / 32), kb = r / (NIN / 32); p0_transpose_item(w_in, D, NIN, Win_t, map_win(32 * nb), 32 * nb, 64 * kb, nullptr, scr, lane); continue; } r -= I_IN;
            if (r < 3 * I_SQ0) { const float* Wsrc = r < I_SQ0 ? w_conv_out : (r < 2 * I_SQ0 ? w_attn_out : w_o); h16_t* Wdst = r < I_SQ0 ? Wc_t : (r < 2 * I_SQ0 ? Wa_t : Wo_t); r %= I_SQ0;
                const int nb = r % (D / 32), kb = r / (D / 32); p0_transpose_item(Wsrc, D, D, Wdst, 32 * nb, 32 * nb, 64 * kb, nullptr, scr, lane); continue; } r -= 3 * I_SQ0;
            if (r < I_GU0) { const int nb = r % (2 * DFF / 32), kb = r / (2 * DFF / 32); p0_transpose_item(w_gate_up, D, 2 * DFF, Wgu_t, map_wgu(32 * nb), 32 * nb, 64 * kb, g_ffn, scr, lane); continue; } r -= I_GU0;
            { const int nb = r % (D / 32), kb = r / (D / 32); p0_transpose_item(w_down, DFF, D, Wd_t, 32 * nb, 32 * nb, 64 * kb, nullptr, scr, lane); }
        }
        {
            f32x4 gq[4];
#pragma unroll
            for (int j = 0; j < 4; ++j) gq[j] = ((const f32x4*)g_mix)[lane + 64 * j];
            for (int m = gw; m < M; m += 4 * NGW) {
                f32x4 xv[4][4];
#pragma unroll
                for (int r = 0; r < 4; ++r) { const f32x4* xr = (const f32x4*)(x + (size_t)(m + r * NGW) * D) + lane;
#pragma unroll
                    for (int j = 0; j < 4; ++j) xv[r][j] = __builtin_nontemporal_load(xr + 64 * j); }
#pragma unroll
                for (int r = 0; r < 4; ++r) {
                    float ss = 0.f;
#pragma unroll
                    for (int j = 0; j < 4; ++j) ss += (xv[r][j][0] * xv[r][j][0] + xv[r][j][1] * xv[r][j][1]) + (xv[r][j][2] * xv[r][j][2] + xv[r][j][3] * xv[r][j][3]);
                    const float rs = 1.0f / sqrtf(wave_sum(ss) * (1.0f / D) + EPS);
                    u32x2* o8 = (u32x2*)(H0 + (size_t)(m + r * NGW) * D) + lane;
#pragma unroll
                    for (int j = 0; j < 4; ++j) { u32x2 w; w.x = cvt_pk_h(xv[r][j][0] * rs * gq[j][0], xv[r][j][1] * rs * gq[j][1]); w.y = cvt_pk_h(xv[r][j][2] * rs * gq[j][2], xv[r][j][3] * rs * gq[j][3]); o8[64 * j] = w; }
                }
            }
        }
        if (tid == 0) __hip_atomic_fetch_or((unsigned*)(ws + WS_GRP) + 64 * (bx & 7) + 32, 1u << xb_xcc_id(), __ATOMIC_RELAXED, __HIP_MEMORY_SCOPE_AGENT);
        for (int i = bx * NTHREADS + tid; i < SEQ * 8; i += G * NTHREADS) {
            const int pos = i >> 3, f = i & 7;
            const float ang = (float)pos * a.inv_freq[f];
            double rev = (double)ang * 0.15915494309189535; rev -= floor(rev);
            const float fr = (float)rev;
            rope[pos * 16 + f] = __builtin_amdgcn_cosf(fr); rope[pos * 16 + 8 + f] = __builtin_amdgcn_sinf(fr);
        }
    }

    const bool heavy = bx < 128; const int pj = (bx >> 3) & 15, my_pm = __builtin_amdgcn_readfirstlane(8 * (bx & 7) + (heavy ? 4 : 0) + (pj >> 2)), my_pn = __builtin_amdgcn_readfirstlane(pj & 3);
    unsigned* const r6 = (unsigned*)(ws + WS_R6); unsigned* const r7 = (unsigned*)(ws + WS_R7); unsigned* const pbar = (unsigned*)(ws + WS_PB) + 64 * my_pm;
    if constexpr (PH == 1) {
        unsigned* const grp = (unsigned*)(ws + WS_GRP) + 64 * (bx & 7);
        const unsigned gm = __hip_atomic_load(grp + 32, __ATOMIC_RELAXED, __HIP_MEMORY_SCOPE_AGENT); const bool samex = (gm & (gm - 1u)) == 0u;
        pg8::Gemm g{H0, Win_t, H0, Win_t, D};
        pg8::ProjOrder S{bx, grp, grp + 16, samex};
        pg8::EpiProj E{CBb, Ub, Qb, Kb, Vb, GCb, GAb};
        pg8::gemm_phase<pg8::EpiProj, pg8::ProjOrder, true>(lds, g, S, E);
        block_wait(grp, 32u * NWAVES);
        if (heavy) block_wait(grp + 16, 16u * NWAVES);
    }

    if constexpr (PH == 2) {
        conv_item(4 * my_pm + my_pn, Ub, CBb, conv_w);
        attn_pair(lds, (((my_pm >> 3) * 4 + my_pn) << 4) + 2 * (my_pm & 7), Qb, Kb, Vb, rope, sinks);
        panel_barrier(pbar, 4u, xb_xcc_id());
    }

    if constexpr (PH == 3) {
        pg8::Gemm g{CBb, Wc_t, Qb, Wa_t, D}; pg8::DualOrder S; S.so.init(M, D, G, (my_pm >> 3) + 8 * (my_pm & 7) + 64 * my_pn);
        pg8::EpiGated E{GCb, GAb};
        pg8::gemm_phase<pg8::EpiGated, pg8::DualOrder, true>(lds, g, S, E);
        panel_barrier(pbar, 8u, xb_xcc_id());
    }

    if constexpr (PH == 4) {
        pg8::Gemm g{GAb, Wo_t, GAb, Wo_t, D}; pg8::StaticOrder S; S.init(M, D, G, (my_pm >> 3) + 8 * (my_pm & 7) + 64 * my_pn);
        pg8::EpiResid E{x, X1B, rp1};
        pg8::gemm_phase<pg8::EpiResid, pg8::StaticOrder, false>(lds, g, S, E);
        {
            unsigned* const grp = (unsigned*)(ws + WS_GRP) + 64 * (bx & 7);
            const unsigned gm = __hip_atomic_load(grp + 32, __ATOMIC_RELAXED, __HIP_MEMORY_SCOPE_AGENT);
            wave_arrive(grp + (heavy ? 48 : 40), (gm & (gm - 1u)) == 0u, lane);
        }
    }

    if constexpr (PH == 5) {
        unsigned* const grp = (unsigned*)(ws + WS_GRP) + 64 * (bx & 7);
        if (!heavy) block_wait(grp + 16, 16u * NWAVES);
        block_wait(grp + (heavy ? 48 : 40), 16u * NWAVES);
        pg8::Gemm g{X1B, Wgu_t, X1B, Wgu_t, D}; pg8::SwiOrder S{bx, grp + 48, 16u * NWAVES};
        pg8::EpiSwiGLU E{ws, rp1};
        pg8::gemm_phase<pg8::EpiSwiGLU, pg8::SwiOrder, true>(lds, g, S, E);
    }

    if constexpr (PH == 6) {
        pg8::Gemm g{(const h16_t*)ws, Wd_t, (const h16_t*)ws, Wd_t, DFF}; pg8::StaticOrder S; S.init(M, D, G, bx, 1);
        pg8::EpiFinal E{X1B, out, g_final, rp2, (unsigned*)(ws + WS_PCNT)};
        pg8::gemm_phase<pg8::EpiFinal, pg8::StaticOrder, false>(lds, g, S, E);
    }

    if constexpr (PH == 7) {
        const int gw = vcu * NWAVES + wave, NGW = G * NWAVES;
        for (int m = gw; m < M; m += NGW) {
            const f32x4 p = *(const f32x4*)(rp2 + (size_t)m * 4);
            const float rs = 1.0f / sqrtf(((p[0] + p[1]) + (p[2] + p[3])) * (1.0f / D) + EPS);
            f32x4* xr = (f32x4*)(out + (size_t)m * D) + lane;
#pragma unroll
            for (int j = 0; j < 4; ++j) { const f32x4 gq = ((const f32x4*)g_final)[lane + 64 * j]; f32x4 v = xr[64 * j]; v = v * rs * gq; xr[64 * j] = v; }
        }
    }
}

__global__ void __launch_bounds__(NTHREADS, 2) fwd_megakernel(Args a) {
    extern __shared__ __attribute__((aligned(16))) unsigned char lds_raw[];
    LAS unsigned char* lds = (LAS unsigned char*)lds_raw;
    if (a.ws == nullptr) { cg::grid_group grid = cg::this_grid(); grid.sync(); }
    volatile LAS unsigned* st = (volatile LAS unsigned*)(lds + LDS_BAR_ST);
    if (threadIdx.x < 2) st[threadIdx.x] = 0u;
    __syncthreads();
    const XcdBarrier bar = xcd_barrier_post((unsigned*)(a.ws + WS_BAR), st);
    run_phase<0>(a, lds); xcd_barrier(bar);
    run_phase<1>(a, lds);
    run_phase<2>(a, lds);
    run_phase<3>(a, lds);
    run_phase<4>(a, lds);
    run_phase<5>(a, lds);
    panel_barrier((unsigned*)(a.ws + WS_GRP + 2048) + 64 * (blockIdx.x & 7), 32u, xb_xcc_id());
    run_phase<6>(a, lds);
}

extern "C" void kernel_launch(void* const* d_in, const int* in_sizes, int n_in, void* d_out, int out_size, void* d_ws, size_t ws_size, hipStream_t stream) {
    static int grid = 0;
    if (grid == 0) {
        if (n_in != 12 || in_sizes[0] != M * D || out_size != M * D || ws_size < WS_END) { fprintf(stderr, "kernel_launch: unexpected shapes (n_in %d, in0 %d, out %d, ws %zu)\n", n_in, n_in > 0 ? in_sizes[0] : -1, out_size, ws_size); grid = -1; return; }
        int dev = 0, cus = 0, per_cu = 0;
        if (hipGetDevice(&dev) != hipSuccess || hipDeviceGetAttribute(&cus, hipDeviceAttributeMultiprocessorCount, dev) != hipSuccess) { grid = -1; return; }
        if (hipFuncSetAttribute((const void*)fwd_megakernel, hipFuncAttributeMaxDynamicSharedMemorySize, LDS_BYTES) != hipSuccess) { fprintf(stderr, "kernel_launch: hipFuncSetAttribute failed\n"); grid = -1; return; }
        if (hipOccupancyMaxActiveBlocksPerMultiprocessor(&per_cu, (const void*)fwd_megakernel, NTHREADS, LDS_BYTES) != hipSuccess || per_cu < 1) { fprintf(stderr, "kernel_launch: occupancy query says %d blocks per CU\n", per_cu); (void)hipGetLastError(); grid = -1; return; }
        if (cus < 256) { fprintf(stderr, "kernel_launch: %d CUs < 256\n", cus); grid = -1; return; }
        grid = 256;
    }
    if (grid < 0) return;
    Args a{};
    for (int i = 0; i < 12; ++i) a.in[i] = (const float*)d_in[i];
    a.out = (float*)d_out; a.ws = (unsigned char*)d_ws;
    for (int i = 0; i < 8; ++i) a.inv_freq[i] = powf(500000.0f, -(float)(2 * i) / 16.0f);
    if (hipMemsetAsync((char*)d_ws + WS_BAR, 0, 65536, stream) != hipSuccess) { fprintf(stderr, "kernel_launch: memset failed\n"); return; }
    void* args[] = {&a};
    hipError_t e = hipLaunchCooperativeKernel((const void*)fwd_megakernel, dim3(grid), dim3(NTHREADS), args, LDS_BYTES, stream);
    if (e != hipSuccess) fprintf(stderr, "kernel_launch: cooperative launch failed: %s\n", hipGetErrorString(e));
}
```

```cpp
#include <hip/hip_runtime.h>
#include <hip/hip_cooperative_groups.h>
#include <cstdio>
#include <cstdint>
#include <cmath>
namespace cg = cooperative_groups;

#define LAS __attribute__((address_space(3)))
typedef unsigned short h16_t;
typedef _Float16 h16x8 __attribute__((ext_vector_type(8)));
typedef _Float16 h16x2 __attribute__((ext_vector_type(2)));
typedef float f32x4 __attribute__((ext_vector_type(4)));
typedef float f32x16 __attribute__((ext_vector_type(16)));
typedef unsigned u32x4 __attribute__((ext_vector_type(4)));
typedef unsigned u32x2 __attribute__((ext_vector_type(2)));

constexpr int D = 1024, BATCH = 8, SEQ = 2048, M = BATCH * SEQ;
constexpr int NH = 16, NKV = 4, HD = 64, DKV = NKV * HD;
constexpr int DFF = 2816, NIN = 6656;
constexpr float EPS = 1e-5f;
constexpr int NWAVES = 8, NTHREADS = 512;

constexpr size_t MiB = 1u << 20;
constexpr size_t WS_ROPE = 0;
constexpr size_t WS_RP1 = 256 * 1024;
constexpr size_t WS_RP2 = 512 * 1024;
constexpr size_t WS_WIN = 1 * MiB;
constexpr size_t WS_WC = 14 * MiB, WS_WA = 16 * MiB, WS_WO = 18 * MiB;
constexpr size_t WS_WGU = 20 * MiB;
constexpr size_t WS_WD = 31 * MiB;
constexpr size_t WS_H0 = 40 * MiB;
constexpr size_t WS_U = 72 * MiB;
constexpr size_t WS_CB = 104 * MiB;
constexpr size_t WS_Q = 136 * MiB;
constexpr size_t WS_K = 168 * MiB, WS_V = 176 * MiB;
constexpr size_t WS_GC = 184 * MiB;
constexpr size_t WS_GA = 216 * MiB;
constexpr size_t WS_ACT = 40 * MiB;
constexpr size_t WS_END = 248 * MiB;

constexpr size_t WS_BAR = 832 * 1024;
constexpr size_t WS_PCNT = WS_BAR + 16384;
constexpr size_t WS_R6 = WS_BAR + 32768, WS_R7 = WS_R6 + 256, WS_PB = WS_R6 + 1024, WS_RX = WS_PB + 16384;
constexpr size_t WS_GRP = WS_BAR + 57344;
constexpr int LDS_BAR_ST = 147456 - 16;
constexpr int LDS_BYTES = 147456;

__device__ __forceinline__ unsigned cvt_pk_h(float lo, float hi) { h16x2 v; v.x = (_Float16)lo; v.y = (_Float16)hi; return __builtin_bit_cast(unsigned, v); }
__device__ __forceinline__ float h_lo(unsigned w) { return (float)__builtin_bit_cast(h16x2, w).x; }
__device__ __forceinline__ float h_hi(unsigned w) { return (float)__builtin_bit_cast(h16x2, w).y; }
__device__ __forceinline__ float sigmoidf_(float x) { return __builtin_amdgcn_rcpf(1.0f + __builtin_amdgcn_exp2f(-1.4426950408889634f * x)); }
__device__ __forceinline__ float wave_sum(float v) {
#pragma unroll
    for (int o = 1; o < 64; o <<= 1) v += __shfl_xor(v, o);
    return v;
}
#define LDS_WAIT() asm volatile("s_waitcnt lgkmcnt(0)" ::: "memory")


#define SYNC_SPIN_CAP (1u << 22)
__device__ __forceinline__ unsigned xb_xcc_id() { return (unsigned)__builtin_amdgcn_s_getreg((3 << 11) | 20) & 0xFu; }
__device__ __forceinline__ void wave_arrive(unsigned* cnt, bool samex, int lane) {
    asm volatile("s_waitcnt vmcnt(0)" ::: "memory");
    if (lane == 0) {
        if (!samex) { __builtin_amdgcn_fence(__ATOMIC_RELEASE, "agent"); asm volatile("s_waitcnt vmcnt(0)" ::: "memory"); }
        __hip_atomic_fetch_add(cnt, 1u, __ATOMIC_RELAXED, __HIP_MEMORY_SCOPE_AGENT);
    }
}
__device__ __forceinline__ void block_wait(unsigned* cnt, unsigned target) {
    if (threadIdx.x == 0) {
        unsigned sp = 0;
        while (__hip_atomic_load(cnt, __ATOMIC_RELAXED, __HIP_MEMORY_SCOPE_AGENT) < target) { __builtin_amdgcn_s_sleep(2); if (++sp > SYNC_SPIN_CAP) break; }
        __builtin_amdgcn_fence(__ATOMIC_ACQUIRE, "agent");
        asm volatile("s_waitcnt vmcnt(0)" ::: "memory");
    }
    __syncthreads();
}
__device__ __forceinline__ void block_wait2(unsigned* cntA, unsigned tgtA, unsigned* cntB, unsigned tgtB) {
    if (threadIdx.x == 0) {
        unsigned sp = 0;
        while (__hip_atomic_load(cntA, __ATOMIC_RELAXED, __HIP_MEMORY_SCOPE_AGENT) < tgtA || __hip_atomic_load(cntB, __ATOMIC_RELAXED, __HIP_MEMORY_SCOPE_AGENT) < tgtB) { __builtin_amdgcn_s_sleep(2); if (++sp > SYNC_SPIN_CAP) break; }
        __builtin_amdgcn_fence(__ATOMIC_ACQUIRE, "agent");
        asm volatile("s_waitcnt vmcnt(0)" ::: "memory");
    }
    __syncthreads();
}
__device__ __forceinline__ void group_barrier(unsigned* cnt, unsigned target, bool samex) {
    asm volatile("s_waitcnt vmcnt(0)" ::: "memory");
    __syncthreads();
    if (threadIdx.x == 0) {
        if (!samex) { __builtin_amdgcn_fence(__ATOMIC_RELEASE, "agent"); asm volatile("s_waitcnt vmcnt(0)" ::: "memory"); }
        __hip_atomic_fetch_add(cnt, 1u, __ATOMIC_RELAXED, __HIP_MEMORY_SCOPE_AGENT);
        unsigned sp = 0;
        while (__hip_atomic_load(cnt, __ATOMIC_RELAXED, __HIP_MEMORY_SCOPE_AGENT) < target) { __builtin_amdgcn_s_sleep(1); if (++sp > SYNC_SPIN_CAP) break; }
        __builtin_amdgcn_fence(__ATOMIC_ACQUIRE, "agent");
        asm volatile("s_waitcnt vmcnt(0)" ::: "memory");
    }
    __syncthreads();
}
__device__ __forceinline__ void panel_barrier(unsigned* cnt, unsigned target, unsigned xcc) {
    asm volatile("s_waitcnt vmcnt(0)" ::: "memory");
    __syncthreads();
    if (threadIdx.x == 0) {
        __hip_atomic_fetch_or(cnt + 1, 1u << xcc, __ATOMIC_RELAXED, __HIP_MEMORY_SCOPE_AGENT);
        asm volatile("s_waitcnt vmcnt(0)" ::: "memory");
        __hip_atomic_fetch_add(cnt, 1u, __ATOMIC_RELAXED, __HIP_MEMORY_SCOPE_AGENT);
        unsigned sp = 0;
        while (__hip_atomic_load(cnt, __ATOMIC_RELAXED, __HIP_MEMORY_SCOPE_AGENT) < target) { __builtin_amdgcn_s_sleep(1); if (++sp > SYNC_SPIN_CAP) break; }
        const unsigned mask = __hip_atomic_load(cnt + 1, __ATOMIC_RELAXED, __HIP_MEMORY_SCOPE_AGENT);
        if (mask & (mask - 1u)) {
            __builtin_amdgcn_fence(__ATOMIC_RELEASE, "agent"); asm volatile("s_waitcnt vmcnt(0)" ::: "memory");
            __hip_atomic_fetch_add(cnt + 2, 1u, __ATOMIC_RELAXED, __HIP_MEMORY_SCOPE_AGENT);
            sp = 0;
            while (__hip_atomic_load(cnt + 2, __ATOMIC_RELAXED, __HIP_MEMORY_SCOPE_AGENT) < target) { __builtin_amdgcn_s_sleep(1); if (++sp > SYNC_SPIN_CAP) break; }
        }
        __builtin_amdgcn_fence(__ATOMIC_ACQUIRE, "agent");
        asm volatile("s_waitcnt vmcnt(0)" ::: "memory");
    }
    __syncthreads();
}

__host__ __device__ __forceinline__ size_t act_slot(int pm) {
    const int g = pm >> 3, l = pm & 7, p = l & 3;
    return ((size_t)(40 + 32 * p + 48 * ((p >> 1) & p)) + 4 * (size_t)g + 2 * (size_t)(l >> 2)) * MiB;
}

namespace pg8 {
constexpr int BM = 256, BK = 64, HALF = 128, HTB = HALF * BK * 2, STAGE_BYTES = 8 * HTB, NXCD = 8, WGM = 8;
__host__ __device__ __forceinline__ int lds_byte(int r, int c) { const int st = (r >> 4) * 2 + (c >> 5), rr = r & 15, cc = c & 31, ob = rr * 64 + cc * 2; return st * 1024 + (ob ^ (((ob >> 9) & 1) << 5)); }
__host__ __device__ __forceinline__ void stage_rc(int b, int& R, int& C) { const int st = b / 1024, sb = b % 1024, swz = sb ^ (((sb >> 9) & 1) << 5); R = (st >> 1) * 16 + swz / 64; C = (st & 1) * 32 + (swz % 64) / 2; }
__host__ __device__ __forceinline__ int perm32(int rho) { const int n = rho >> 4, i = rho & 15; return 8 * (i >> 2) + 4 * n + (i & 3); }

struct Unit { int pm, pn, z; long long aoff; };
struct Gemm { const h16_t* A0; const h16_t* B0; const h16_t* A1; const h16_t* B1; int K; };

struct StaticOrder {
    int nM, nN, nwg, G, c, act;
    __device__ void init(int M_, int N_, int G_, int c_, int act_ = 0) { nM = M_ / BM; nN = N_ / BM; nwg = nM * nN; G = G_; c = c_; act = act_; }
    __device__ bool next(int i, Unit& u) const {
        const long L = (long)i * G + c; if (L >= nwg) return false;
        int wgid = (int)L; { const int q = nwg / NXCD, r = nwg % NXCD, xcd = wgid % NXCD, off = wgid / NXCD; wgid = (xcd < r ? xcd * (q + 1) : r * (q + 1) + (xcd - r) * q) + off; }
        const int nig = WGM * nN, gid = wgid / nig, fm = gid * WGM, gsz = (nM - fm) < WGM ? (nM - fm) : WGM;
        u.pm = fm + ((wgid % nig) % gsz); u.pn = (wgid % nig) / gsz; u.z = 0; u.aoff = act ? (long long)act_slot(u.pm) : -1; return true;
    }
    __device__ __forceinline__ void done(int, int) const {}
};
struct DualOrder {
    StaticOrder so;
    __device__ bool next(int i, Unit& u) const { if (i >= 2) return false; if (!so.next(0, u)) return false; u.z = i; return true; }
    __device__ __forceinline__ void done(int, int) const {}
};
struct ProjOrder {
    int c; unsigned* r6; unsigned* r7; bool samex;
    __device__ bool next(int i, Unit& u) const {
        const int idx = 32 * i + (c >> 3); if (idx >= 208) return false;
        int pm, pn;
        if (idx < 176) { pm = idx & 7; pn = idx >> 3; } else if (idx < 192) { const int j = idx - 176; pm = j & 3; pn = 22 + (j >> 2); } else { const int j = idx - 192; pm = 4 + (j & 3); pn = 22 + (j >> 2); }
        u.pm = 8 * (c & 7) + pm; u.pn = pn; u.z = 0; u.aoff = -1; return true;
    }
    __device__ __forceinline__ void done(int ui, int lane) const { if (ui == 5) wave_arrive(r6, samex, lane); if (ui == 6) wave_arrive(r7, samex, lane); }
};
struct SwiOrder {
    int c; unsigned* l4; unsigned tgt;
    __device__ __forceinline__ bool next(int i, Unit& u) const {
        const int idx = 16 * i + ((c >> 3) & 15); int pm, pn;
        if (c >= 128) {
            if (idx >= 96) return false;
            if (idx < 88) { pm = idx & 3; pn = idx >> 2; }
            else { const int k = idx - 88; pm = 4 + (k & 3); pn = 20 + (k >> 2);
                unsigned sp = 0;
                while (__hip_atomic_load(l4, __ATOMIC_RELAXED, __HIP_MEMORY_SCOPE_AGENT) < tgt) { __builtin_amdgcn_s_sleep(2); if (++sp > SYNC_SPIN_CAP) break; }
                __builtin_amdgcn_fence(__ATOMIC_ACQUIRE, "agent"); }
        } else { if (idx >= 80) return false; pm = 4 + (idx & 3); pn = idx >> 2; }
        u.pm = 8 * (c & 7) + pm; u.pn = pn; u.z = 0; u.aoff = -1; return true;
    }
    __device__ __forceinline__ void done(int, int) const {}
};
__device__ __forceinline__ void panel_of(int c, int& pm, int& pn) { const int pj = (c >> 3) & 15; pm = 8 * (c & 7) + ((c < 128) ? 4 : 0) + (pj >> 2); pn = pj & 3; }
struct PanelDual {
    int c, n;
    __device__ bool next(int i, Unit& u) const { if (i >= n) return false; panel_of(c, u.pm, u.pn); u.z = i; u.aoff = -1; return true; }
    __device__ __forceinline__ void done(int, int) const {}
};
struct PanelOne {
    int c, n;
    __device__ bool next(int i, Unit& u) const { if (i >= n) return false; panel_of(c, u.pm, u.pn); u.z = 0; u.aoff = -1; return true; }
    __device__ __forceinline__ void done(int, int) const {}
};

template <class Epi, class Sched, bool ALIGN_EPI>
__device__ __forceinline__ void gemm_phase(LAS unsigned char* lds, const Gemm g, const Sched& S, const Epi& E) {
    const int tid = threadIdx.x, wid = __builtin_amdgcn_readfirstlane(tid >> 6), lane = tid & 63, wr = wid >> 2, wc = wid & 3, fr = lane & 15, fq = lane >> 4;
    const int K = g.K, nt = K / BK;
    unsigned voffA[2], voffB[2];
#pragma unroll
    for (int i = 0; i < 2; ++i) { int R, C; stage_rc(tid * 16 + i * 8192, R, C); const int Rb = (R & ~31) + perm32(R & 31);
        voffA[i] = (unsigned)(R * K + C) * 2u; voffB[i] = (unsigned)(Rb * K + C) * 2u; }
    const size_t kstep = (size_t)(BK * 2);
    const size_t hstep = (size_t)HALF * K * 2;
    const size_t tstep = 2 * hstep;
    const unsigned ldsw = (unsigned)wid * 1024u;
    const int aoff = lds_byte(wr * 64 + fr, fq * 8), boff = lds_byte(wc * 32 + fr, fq * 8);
#define PG8_SA(b, h) (((b) * 2 + (h)) * HTB)
#define PG8_SB(b, h) ((4 + (b) * 2 + (h)) * HTB)
#define PG8_STAGE(bufoff, gbase, voff) do { _Pragma("unroll") for (int _i = 0; _i < 2; ++_i) \
        __builtin_amdgcn_global_load_lds((const unsigned*)((const char*)(gbase) + (voff)[_i]), (LAS unsigned*)(lds + (bufoff) + ldsw + _i * 8192), 16, 0, 0); } while (0)
#define PG8_LDA(dst, b, h) do { _Pragma("unroll") for (int m = 0; m < 4; ++m) _Pragma("unroll") for (int k = 0; k < 2; ++k) dst[m][k] = *(const LAS h16x8*)(lds + PG8_SA(b, h) + aoff + m * 2048 + k * 1024); } while (0)
#define PG8_LDB(dst, b, h) do { _Pragma("unroll") for (int n = 0; n < 2; ++n) _Pragma("unroll") for (int k = 0; k < 2; ++k) dst[n][k] = *(const LAS h16x8*)(lds + PG8_SB(b, h) + boff + n * 2048 + k * 1024); } while (0)
#define PG8_MMA(ai, bj, At, Bt) do { __builtin_amdgcn_s_setprio(1); _Pragma("unroll") for (int m = 0; m < 4; ++m) _Pragma("unroll") for (int n = 0; n < 2; ++n) _Pragma("unroll") for (int k = 0; k < 2; ++k) \
        acc[ai][bj][m][n] = __builtin_amdgcn_mfma_f32_16x16x32_f16(Bt[n][k], At[m][k], acc[ai][bj][m][n], 0, 0, 0); __builtin_amdgcn_s_setprio(0); } while (0)
#define PG8_WAIT_V(n) asm volatile("s_waitcnt vmcnt(" #n ")" ::: "memory")
#define PG8_WAIT_L(n) asm volatile("s_waitcnt lgkmcnt(" #n ")" ::: "memory")
#define PG8_BAR __builtin_amdgcn_s_barrier()
#define PG8_SCHED __builtin_amdgcn_sched_barrier(0)
    Unit cur, nxt; int ui = 0;
    if (!S.next(0, cur)) return;
    f32x4 acc[2][2][4][2]; typename Epi::Tmp itmp;
    E.init_acc(acc, itmp, cur, wr, wc, fr, fq);
    h16x8 At[4][2], B0[2][2], B1[2][2];
    const char* cA = cur.aoff >= 0 ? (const char*)g.A0 + cur.aoff : (const char*)(cur.z ? g.A1 : g.A0) + (size_t)cur.pm * tstep; const char* cB = (const char*)(cur.z ? g.B1 : g.B0) + (size_t)cur.pn * tstep;
    PG8_STAGE(PG8_SB(0, 0), cB, voffB); PG8_STAGE(PG8_SB(0, 1), cB + hstep, voffB); PG8_STAGE(PG8_SA(0, 0), cA, voffA); PG8_STAGE(PG8_SA(0, 1), cA + hstep, voffA);
    if (wr == 1) PG8_BAR;
    PG8_WAIT_V(2); PG8_BAR;
    PG8_STAGE(PG8_SB(1, 0), cB + kstep, voffB); PG8_STAGE(PG8_SA(1, 0), cA + kstep, voffA); PG8_STAGE(PG8_SB(1, 1), cB + hstep + kstep, voffB);
    PG8_WAIT_V(6); PG8_BAR;
    E.finish_acc(acc, itmp);
    for (;;) {
        const bool has_next = S.next(ui + 1, nxt);
        const char* nA = has_next ? (nxt.aoff >= 0 ? (const char*)g.A0 + nxt.aoff : (const char*)(nxt.z ? g.A1 : g.A0) + (size_t)nxt.pm * tstep) : cA; const char* nB = has_next ? (const char*)(nxt.z ? g.B1 : g.B0) + (size_t)nxt.pn * tstep : cB;
        for (int t = 0; t < nt; t += 2) {
            const bool last = (t == nt - 2);
            const char* a1 = cA + (size_t)(t + 1) * kstep;
            const char* a2 = last ? nA : cA + (size_t)(t + 2) * kstep; const char* b2 = last ? nB : cB + (size_t)(t + 2) * kstep;
            const char* a3 = a2 + kstep; const char* b3 = b2 + kstep;
            PG8_LDB(B0, 0, 0); PG8_LDB(B1, 0, 1); PG8_SCHED; PG8_LDA(At, 0, 0); PG8_STAGE(PG8_SA(1, 1), a1 + hstep, voffA);
            PG8_WAIT_V(8); PG8_WAIT_L(0); PG8_BAR; PG8_MMA(0, 0, At, B0); PG8_MMA(0, 1, At, B1); PG8_BAR; PG8_SCHED;
            PG8_LDA(At, 0, 1); PG8_STAGE(PG8_SB(0, 0), b2, voffB); PG8_STAGE(PG8_SB(0, 1), b2 + hstep, voffB); PG8_STAGE(PG8_SA(0, 0), a2, voffA);
            PG8_WAIT_V(8); PG8_WAIT_L(0); PG8_BAR; PG8_MMA(1, 0, At, B0); PG8_MMA(1, 1, At, B1); PG8_BAR; PG8_SCHED;
            PG8_LDB(B0, 1, 0); PG8_LDB(B1, 1, 1); PG8_SCHED; PG8_LDA(At, 1, 0); PG8_STAGE(PG8_SA(0, 1), a2 + hstep, voffA);
            PG8_WAIT_V(8); PG8_WAIT_L(0); PG8_BAR; PG8_MMA(0, 0, At, B0); PG8_MMA(0, 1, At, B1); PG8_BAR; PG8_SCHED;
            PG8_LDA(At, 1, 1); PG8_STAGE(PG8_SB(1, 0), b3, voffB); PG8_STAGE(PG8_SB(1, 1), b3 + hstep, voffB); PG8_STAGE(PG8_SA(1, 0), a3, voffA);
            PG8_WAIT_V(8); PG8_WAIT_L(0); PG8_BAR; PG8_MMA(1, 0, At, B0); PG8_MMA(1, 1, At, B1); PG8_BAR; PG8_SCHED;
        }
        if constexpr (ALIGN_EPI) { if (wr == 0) PG8_BAR; }
        if constexpr (!Epi::AFTER_DRAIN) { E(acc, cur, wr, wc, fr, fq); S.done(ui, lane); }
        if (!has_next) break;
        if (!Epi::keep_acc(cur))
#pragma unroll
        for (int a = 0; a < 2; ++a)
#pragma unroll
            for (int b = 0; b < 2; ++b)
#pragma unroll
                for (int m = 0; m < 4; ++m)
#pragma unroll
                    for (int n = 0; n < 2; ++n) acc[a][b][m][n] = (f32x4){0.f, 0.f, 0.f, 0.f};
        cur = nxt; cA = nA; cB = nB; ++ui;
        if constexpr (ALIGN_EPI) { if (wr == 1) PG8_BAR; }
    }
    PG8_WAIT_V(0);
    if constexpr (!ALIGN_EPI) { if (wr == 0) PG8_BAR; }
    PG8_BAR;
    if constexpr (Epi::AFTER_DRAIN) { E.fused(acc, cur, wr, wc, fr, fq, lds, wid, lane); }
#undef PG8_SA
#undef PG8_SB
#undef PG8_STAGE
#undef PG8_LDA
#undef PG8_LDB
#undef PG8_MMA
#undef PG8_WAIT_V
#undef PG8_WAIT_L
#undef PG8_BAR
#undef PG8_SCHED
}

__device__ __forceinline__ u32x4 pack8(const f32x4 v0, const f32x4 v1) { u32x4 w; w.x = cvt_pk_h(v0[0], v0[1]); w.y = cvt_pk_h(v0[2], v0[3]); w.z = cvt_pk_h(v1[0], v1[1]); w.w = cvt_pk_h(v1[2], v1[3]); return w; }

struct EpiProj {
    static constexpr bool AFTER_DRAIN = false;
    struct Tmp {};
    __device__ __forceinline__ void init_acc(f32x4 (&acc)[2][2][4][2], Tmp&, const Unit&, int, int, int, int) const {
#pragma unroll
        for (int a = 0; a < 2; ++a)
#pragma unroll
            for (int b = 0; b < 2; ++b)
#pragma unroll
                for (int m = 0; m < 4; ++m)
#pragma unroll
                    for (int n = 0; n < 2; ++n) acc[a][b][m][n] = (f32x4){0.f, 0.f, 0.f, 0.f};
    }
    __device__ __forceinline__ void finish_acc(f32x4 (&)[2][2][4][2], Tmp&) const {}
    static __device__ __forceinline__ bool keep_acc(const Unit&) { return false; }
    h16_t *CB, *U, *Q, *Kb, *Vb, *GC, *GA;
    __device__ __forceinline__ void operator()(f32x4 (&acc)[2][2][4][2], const Unit& u, int wr, int wc, int fr, int fq) const {
        const int pn = u.pn, row0 = u.pm * BM + wr * 64 + fr;
        if (pn >= 4 && pn < 12) {
            const int col = 128 * (pn - 4) + 32 * wc + 8 * fq;
#pragma unroll
            for (int ai = 0; ai < 2; ++ai)
#pragma unroll
                for (int m = 0; m < 4; ++m) {
                    const f32x4 v0 = acc[ai][0][m][0] * acc[ai][1][m][0], v1 = acc[ai][0][m][1] * acc[ai][1][m][1];
                    *(u32x4*)(U + (size_t)(row0 + ai * HALF + m * 16) * D + col) = pack8(v0, v1);
                }
        } else if (pn >= 18) {
            const int col = 128 * (pn - 18) + 32 * wc + 8 * fq;
#pragma unroll
            for (int ai = 0; ai < 2; ++ai)
#pragma unroll
                for (int m = 0; m < 4; ++m) {
                    f32x4 r0, r1, a0, a1;
#pragma unroll
                    for (int e = 0; e < 4; ++e) { a0[e] = fmaxf(sigmoidf_(acc[ai][1][m][0][e]), 6.103515625e-5f); a1[e] = fmaxf(sigmoidf_(acc[ai][1][m][1][e]), 6.103515625e-5f); }
                    const u32x4 aw = pack8(a0, a1);
                    a0[0] = h_lo(aw.x); a0[1] = h_hi(aw.x); a0[2] = h_lo(aw.y); a0[3] = h_hi(aw.y); a1[0] = h_lo(aw.z); a1[1] = h_hi(aw.z); a1[2] = h_lo(aw.w); a1[3] = h_hi(aw.w);
#pragma unroll
                    for (int e = 0; e < 4; ++e) { r0[e] = sigmoidf_(acc[ai][0][m][0][e]) * __builtin_amdgcn_rcpf(a0[e]); r1[e] = sigmoidf_(acc[ai][0][m][1][e]) * __builtin_amdgcn_rcpf(a1[e]); }
                    const size_t off = (size_t)(row0 + ai * HALF + m * 16) * D + col;
                    *(u32x4*)(GC + off) = pack8(r0, r1);
                    *(u32x4*)(GA + off) = aw;
                }
        } else {
            h16_t* base; int ldc = D, colt; float sc = 1.f;
            if (pn < 4) { base = CB; colt = pn * 256; }
            else if (pn < 16) { base = Q; colt = (pn - 12) * 256; sc = 0.125f * 1.4426950408889634f; }
            else if (pn == 16) { base = Kb; colt = 0; ldc = DKV; }
            else { base = Vb; colt = 0; ldc = DKV; }
            const int col = colt + 32 * wc + 8 * fq;
#pragma unroll
            for (int ai = 0; ai < 2; ++ai)
#pragma unroll
                for (int m = 0; m < 4; ++m) { h16_t* rowp = base + (size_t)(row0 + ai * HALF + m * 16) * ldc + col;
#pragma unroll
                    for (int bj = 0; bj < 2; ++bj) { f32x4 v0 = acc[ai][bj][m][0], v1 = acc[ai][bj][m][1];
                        v0 = v0 * sc; v1 = v1 * sc;
                        *(u32x4*)(rowp + bj * HALF) = pack8(v0, v1); } }
        }
    }
};

struct EpiGated {
    static constexpr bool AFTER_DRAIN = false;
    struct Tmp {};
    __device__ __forceinline__ void init_acc(f32x4 (&acc)[2][2][4][2], Tmp&, const Unit&, int, int, int, int) const {
#pragma unroll
        for (int a = 0; a < 2; ++a)
#pragma unroll
            for (int b = 0; b < 2; ++b)
#pragma unroll
                for (int m = 0; m < 4; ++m)
#pragma unroll
                    for (int n = 0; n < 2; ++n) acc[a][b][m][n] = (f32x4){0.f, 0.f, 0.f, 0.f};
    }
    __device__ __forceinline__ void finish_acc(f32x4 (&)[2][2][4][2], Tmp&) const {}
    static __device__ __forceinline__ bool keep_acc(const Unit& u) { return u.z == 0; }
    const h16_t* R; h16_t* SA;
    __device__ __forceinline__ void operator()(f32x4 (&acc)[2][2][4][2], const Unit& u, int wr, int wc, int fr, int fq) const {
        const int row0 = u.pm * BM + wr * 64 + fr, col0 = u.pn * BM + 32 * wc + 8 * fq;
        if (u.z == 0) {
#pragma unroll
            for (int ai = 0; ai < 2; ++ai)
#pragma unroll
                for (int m = 0; m < 4; ++m)
#pragma unroll
                    for (int bj = 0; bj < 2; ++bj) {
                        const size_t off = (size_t)(row0 + ai * HALF + m * 16) * D + col0 + bj * HALF;
                        const u32x4 gw = *(const u32x4*)(R + off);
                        f32x4 v0 = acc[ai][bj][m][0], v1 = acc[ai][bj][m][1];
                        v0[0] *= h_lo(gw.x); v0[1] *= h_hi(gw.x); v0[2] *= h_lo(gw.y); v0[3] *= h_hi(gw.y);
                        v1[0] *= h_lo(gw.z); v1[1] *= h_hi(gw.z); v1[2] *= h_lo(gw.w); v1[3] *= h_hi(gw.w);
                        acc[ai][bj][m][0] = v0; acc[ai][bj][m][1] = v1;
                    }
        } else {
#pragma unroll
            for (int ai = 0; ai < 2; ++ai)
#pragma unroll
                for (int m = 0; m < 4; ++m)
#pragma unroll
                    for (int bj = 0; bj < 2; ++bj) {
                        const size_t off = (size_t)(row0 + ai * HALF + m * 16) * D + col0 + bj * HALF;
                        const u32x4 gw = *(const u32x4*)(SA + off);
                        f32x4 v0 = acc[ai][bj][m][0], v1 = acc[ai][bj][m][1];
                        v0[0] *= h_lo(gw.x); v0[1] *= h_hi(gw.x); v0[2] *= h_lo(gw.y); v0[3] *= h_hi(gw.y);
                        v1[0] *= h_lo(gw.z); v1[1] *= h_hi(gw.z); v1[2] *= h_lo(gw.w); v1[3] *= h_hi(gw.w);
                        *(u32x4*)(SA + off) = pack8(v0, v1);
                    }
        }
    }
};

struct EpiResid {
    static constexpr bool AFTER_DRAIN = true;
    struct Tmp {};
    __device__ __forceinline__ void init_acc(f32x4 (&acc)[2][2][4][2], Tmp&, const Unit& u, int wr, int wc, int fr, int fq) const {
        const int col0 = u.pn * BM + 32 * wc + 8 * fq;
#pragma unroll
        for (int ai = 0; ai < 2; ++ai)
#pragma unroll
            for (int m = 0; m < 4; ++m) { const size_t off = (size_t)(u.pm * BM + ai * HALF + wr * 64 + m * 16 + fr) * D + col0;
#pragma unroll
                for (int bj = 0; bj < 2; ++bj) { acc[ai][bj][m][0] = *(const f32x4*)(base + off + bj * HALF); acc[ai][bj][m][1] = *(const f32x4*)(base + off + bj * HALF + 4); } }
    }
    __device__ __forceinline__ void finish_acc(f32x4 (&)[2][2][4][2], Tmp&) const {}
    static __device__ __forceinline__ bool keep_acc(const Unit&) { return false; }
    const float* base; h16_t* xh; float* rowpart;
    __device__ __forceinline__ void fused(f32x4 (&acc)[2][2][4][2], const Unit& u, int wr, int wc, int fr, int fq, LAS unsigned char* lds, int wid, int lane) const {
        LAS float* P = (LAS float*)lds;
        const int col0 = u.pn * BM + 32 * wc + 8 * fq;
#pragma unroll
        for (int ai = 0; ai < 2; ++ai)
#pragma unroll
            for (int m = 0; m < 4; ++m) {
                const int rl = ai * HALF + wr * 64 + m * 16 + fr; const size_t off = (size_t)(u.pm * BM + rl) * D + col0;
                float ss = 0.f;
#pragma unroll
                for (int bj = 0; bj < 2; ++bj) {
                    const f32x4 v0 = acc[ai][bj][m][0], v1 = acc[ai][bj][m][1];
                    *(u32x4*)(xh + off + bj * HALF) = pack8(v0, v1);
                    ss += (v0[0] * v0[0] + v0[1] * v0[1]) + (v0[2] * v0[2] + v0[3] * v0[3]) + (v1[0] * v1[0] + v1[1] * v1[1]) + (v1[2] * v1[2] + v1[3] * v1[3]);
                }
                ss += __shfl_xor(ss, 16); ss += __shfl_xor(ss, 32);
                if (fq == 0) P[rl * 4 + wc] = ss;
            }
        __syncthreads();
        const int tid = wid * 64 + lane;
        if (tid < 256) { const f32x4 p = *(const LAS f32x4*)(P + tid * 4); rowpart[(size_t)(u.pm * BM + tid) * 4 + u.pn] = (p[0] + p[1]) + (p[2] + p[3]); }
    }
};

struct EpiSwiGLU {
    static constexpr bool AFTER_DRAIN = false;
    struct Tmp {};
    __device__ __forceinline__ void init_acc(f32x4 (&acc)[2][2][4][2], Tmp&, const Unit&, int, int, int, int) const {
#pragma unroll
        for (int a = 0; a < 2; ++a)
#pragma unroll
            for (int b = 0; b < 2; ++b)
#pragma unroll
                for (int m = 0; m < 4; ++m)
#pragma unroll
                    for (int n = 0; n < 2; ++n) acc[a][b][m][n] = (f32x4){0.f, 0.f, 0.f, 0.f};
    }
    __device__ __forceinline__ void finish_acc(f32x4 (&)[2][2][4][2], Tmp&) const {}
    static __device__ __forceinline__ bool keep_acc(const Unit&) { return false; }
    unsigned char* wsb; const float* rowpart;
    __device__ __forceinline__ void operator()(f32x4 (&acc)[2][2][4][2], const Unit& u, int wr, int wc, int fr, int fq) const {
        const int row0 = u.pm * BM + wr * 64 + fr, col = 128 * u.pn + 32 * wc + 8 * fq;
        h16_t* ACT = (h16_t*)(wsb + act_slot(u.pm)) - (size_t)(u.pm * BM) * DFF;
#pragma unroll
        for (int ai = 0; ai < 2; ++ai)
#pragma unroll
            for (int m = 0; m < 4; ++m) {
                const int row = row0 + ai * HALF + m * 16;
                const f32x4 p = *(const f32x4*)(rowpart + (size_t)row * 4);
                const float rs = 1.0f / sqrtf(((p[0] + p[1]) + (p[2] + p[3])) * (1.0f / D) + EPS);
                f32x4 o[2];
#pragma unroll
                for (int n = 0; n < 2; ++n)
#pragma unroll
                    for (int e = 0; e < 4; ++e) { const float gv = acc[ai][0][m][n][e] * rs, uv = acc[ai][1][m][n][e] * rs; o[n][e] = gv * sigmoidf_(gv) * uv; }
                *(u32x4*)(ACT + (size_t)row * DFF + col) = pack8(o[0], o[1]);
            }
    }
};

struct EpiFinal {
    static constexpr bool AFTER_DRAIN = true;
    struct Tmp { u32x4 w[2][4][2]; };
    __device__ __forceinline__ void init_acc(f32x4 (&)[2][2][4][2], Tmp& t, const Unit& u, int wr, int wc, int fr, int fq) const {
        const int col0 = u.pn * BM + 32 * wc + 8 * fq;
#pragma unroll
        for (int ai = 0; ai < 2; ++ai)
#pragma unroll
            for (int m = 0; m < 4; ++m) { const size_t off = (size_t)(u.pm * BM + ai * HALF + wr * 64 + m * 16 + fr) * D + col0;
#pragma unroll
                for (int bj = 0; bj < 2; ++bj) t.w[ai][m][bj] = *(const u32x4*)(xh + off + bj * HALF); }
    }
    __device__ __forceinline__ void finish_acc(f32x4 (&acc)[2][2][4][2], Tmp& t) const {
#pragma unroll
        for (int ai = 0; ai < 2; ++ai)
#pragma unroll
            for (int m = 0; m < 4; ++m)
#pragma unroll
                for (int bj = 0; bj < 2; ++bj) { const u32x4 hw = t.w[ai][m][bj];
                    acc[ai][bj][m][0] = (f32x4){h_lo(hw.x), h_hi(hw.x), h_lo(hw.y), h_hi(hw.y)}; acc[ai][bj][m][1] = (f32x4){h_lo(hw.z), h_hi(hw.z), h_lo(hw.w), h_hi(hw.w)}; }
    }
    static __device__ __forceinline__ bool keep_acc(const Unit&) { return false; }
    const h16_t* xh; float* out; const float* gfin; float* slots; unsigned* cnt;
    __device__ __forceinline__ void fused(f32x4 (&acc)[2][2][4][2], const Unit& u, int wr, int wc, int fr, int fq, LAS unsigned char* lds, int wid, int lane) const {
        LAS float* P = (LAS float*)lds;
        LAS float* S = (LAS float*)(lds + 4096);
        const int col0 = u.pn * BM + 32 * wc + 8 * fq;
#pragma unroll
        for (int ai = 0; ai < 2; ++ai)
#pragma unroll
            for (int m = 0; m < 4; ++m) {
                const int rl = ai * HALF + wr * 64 + m * 16 + fr; const size_t off = (size_t)(u.pm * BM + rl) * D + col0;
                float ss = 0.f;
#pragma unroll
                for (int bj = 0; bj < 2; ++bj) {
                    const f32x4 v0 = acc[ai][bj][m][0], v1 = acc[ai][bj][m][1];
                    ss += (v0[0] * v0[0] + v0[1] * v0[1]) + (v0[2] * v0[2] + v0[3] * v0[3]) + (v1[0] * v1[0] + v1[1] * v1[1]) + (v1[2] * v1[2] + v1[3] * v1[3]);
                }
                ss += __shfl_xor(ss, 16); ss += __shfl_xor(ss, 32);
                if (fq == 0) P[rl * 4 + wc] = ss;
            }
        __syncthreads();
        const int tid = wid * 64 + lane;
        if (tid < 256) { const f32x4 p = *(const LAS f32x4*)(P + tid * 4);
            __hip_atomic_store(slots + (size_t)(u.pm * BM + tid) * 4 + u.pn, (p[0] + p[1]) + (p[2] + p[3]), __ATOMIC_RELAXED, __HIP_MEMORY_SCOPE_AGENT); }
        asm volatile("s_waitcnt vmcnt(0)" ::: "memory");
        if (tid < 256 && lane == 0) __hip_atomic_fetch_add(cnt + 64 * u.pm, 1u, __ATOMIC_RELAXED, __HIP_MEMORY_SCOPE_AGENT);
        if (wid == 0) {
            unsigned sp = 0;
            while ((unsigned)__builtin_amdgcn_readfirstlane(__hip_atomic_load(cnt + 64 * u.pm, __ATOMIC_RELAXED, __HIP_MEMORY_SCOPE_AGENT)) < 16u) { __builtin_amdgcn_s_sleep(1); if (++sp > (1u << 22)) break; }
            __builtin_amdgcn_fence(__ATOMIC_ACQUIRE, "agent");
        }
        asm volatile("s_waitcnt vmcnt(0) lgkmcnt(0)" ::: "memory");
        __syncthreads();
        if (tid < 256) { const float* sl = slots + (size_t)(u.pm * BM + tid) * 4; float t = 0.f;
#pragma unroll
            for (int q = 0; q < 4; ++q) t += __hip_atomic_load(sl + q, __ATOMIC_RELAXED, __HIP_MEMORY_SCOPE_AGENT);
            S[tid] = 1.0f / sqrtf(t * (1.0f / D) + EPS); }
        __syncthreads();
        f32x4 gv[2][2];
#pragma unroll
        for (int bj = 0; bj < 2; ++bj) { gv[bj][0] = *(const f32x4*)(gfin + col0 + bj * HALF); gv[bj][1] = *(const f32x4*)(gfin + col0 + bj * HALF + 4); }
#pragma unroll
        for (int ai = 0; ai < 2; ++ai)
#pragma unroll
            for (int m = 0; m < 4; ++m) {
                const int rl = ai * HALF + wr * 64 + m * 16 + fr; const size_t off = (size_t)(u.pm * BM + rl) * D + col0; const float rs = S[rl];
#pragma unroll
                for (int bj = 0; bj < 2; ++bj) { *(f32x4*)(out + off + bj * HALF) = acc[ai][bj][m][0] * rs * gv[bj][0]; *(f32x4*)(out + off + bj * HALF + 4) = acc[ai][bj][m][1] * rs * gv[bj][1]; }
            }
    }
};
}

__device__ __forceinline__ void p0_transpose_item(const float* W, int K, int N, h16_t* WT, int dst_row0, int n0, int k0, const float* kscale, LAS unsigned* scr, int lane) {
    const int nq = lane & 7, kq = lane >> 3;
    f32x4 ra[4], rb[4];
#pragma unroll
    for (int t = 0; t < 4; ++t) { const int kp = kq + 8 * t; const float* p = W + (size_t)(k0 + 2 * kp) * N + n0 + 4 * nq; ra[t] = __builtin_nontemporal_load((const f32x4*)p); rb[t] = __builtin_nontemporal_load((const f32x4*)(p + N)); }
#pragma unroll
    for (int t = 0; t < 4; ++t) { const int kp = kq + 8 * t; float s0 = 1.f, s1 = 1.f; if (kscale) { s0 = kscale[k0 + 2 * kp]; s1 = kscale[k0 + 2 * kp + 1]; }
#pragma unroll
        for (int i = 0; i < 4; ++i) scr[(4 * nq + i) * 33 + kp] = cvt_pk_h(ra[t][i] * s0, rb[t][i] * s1); }
    LDS_WAIT(); asm volatile("" ::: "memory");
    const int c = lane & 7;
#pragma unroll
    for (int j = 0; j < 4; ++j) { const int n = (lane >> 3) + 8 * j; const LAS unsigned* sp = scr + n * 33 + 4 * c;
        u32x4 o; o.x = sp[0]; o.y = sp[1]; o.z = sp[2]; o.w = sp[3];
        *(u32x4*)(WT + (size_t)(dst_row0 + n) * K + k0 + 8 * c) = o; }
    LDS_WAIT(); asm volatile("" ::: "memory");
}
__device__ __forceinline__ int map_win(int n) {
    if (n < 1024 || (n >= 3072 && n < 4608)) return n;
    if (n >= 4608) { const int c = (n - 4608) & 1023, isa = (n >= 5632) ? 1 : 0; return 4608 + 256 * (c >> 7) + 128 * isa + (c & 127); }
    const int c = (n - 1024) & 1023, isx = (n >= 2048) ? 1 : 0;
    return 1024 + 256 * (c >> 7) + 128 * isx + (c & 127);
}
__device__ __forceinline__ int map_wgu(int n) {
    const int isu = (n >= DFF) ? 1 : 0, c = n - isu * DFF;
    return 256 * (c >> 7) + 128 * isu + (c & 127);
}

constexpr int KS_STRIDE = 72, VT_STRIDE = 264;
constexpr int LDS_KS = 0, LDS_VT = 256 * KS_STRIDE * 2;

constexpr int ATT_UNIT_LDS = 70656;
struct QRaw { u32x4 a0, a1; h16x8 q1, q2, q3; f32x4 c0, c1, s0, s1; };
__device__ __forceinline__ void attn_qload(QRaw& r, const h16_t* qp, const float* ropep, int hi) {
    r.a0 = *(const u32x4*)qp; r.a1 = *(const u32x4*)(qp + 8);
    r.q1 = *(const h16x8*)(qp + 16 + 8 * hi); r.q2 = *(const h16x8*)(qp + 32 + 8 * hi); r.q3 = *(const h16x8*)(qp + 48 + 8 * hi);
    const f32x4* cs = (const f32x4*)ropep; r.c0 = cs[0]; r.c1 = cs[1]; r.s0 = cs[2]; r.s1 = cs[3];
}
__device__ __forceinline__ void attn_pair(LAS unsigned char* lds, int un0, h16_t* QO, const h16_t* Kb, const h16_t* Vb, const float* rope, const float* sinks) {
    const int tid = threadIdx.x, lane = tid & 63, wid = __builtin_amdgcn_readfirstlane(tid >> 6);
    const int qi = lane & 31, hi = lane >> 5;
    QRaw qc;
    {
        const int blk = un0 & 15, kvh = (un0 >> 4) & 3, b = un0 >> 6, head = kvh * 4 + (wid >> 1);
        const int qpos = blk * 128 + ((wid & 1) * 2) * 32 + qi;
        attn_qload(qc, QO + ((size_t)b * SEQ + qpos) * D + head * HD, rope + (size_t)qpos * 16, hi);
    }
    {
        const int kk = tid >> 1, half = tid & 1;
        u32x4 kv[2][4], vv[2][4]; f32x4 cs[2][4];
#pragma unroll
        for (int uu = 0; uu < 2; ++uu) {
            const int un = un0 + uu, blk = un & 15, kvh = (un >> 4) & 3, b = un >> 6;
            const int pos = blk * 128 - 128 + kk;
#pragma unroll
            for (int i = 0; i < 4; ++i) { kv[uu][i] = (u32x4){0u, 0u, 0u, 0u}; vv[uu][i] = (u32x4){0u, 0u, 0u, 0u}; cs[uu][i] = (f32x4){0.f, 0.f, 0.f, 0.f}; }
            if (pos >= 0) {
                const size_t row = (size_t)b * SEQ + pos;
                const u32x4* kp = (const u32x4*)(Kb + row * DKV + kvh * HD + half * 32);
                const u32x4* vp = (const u32x4*)(Vb + row * DKV + kvh * HD + half * 32);
#pragma unroll
                for (int i = 0; i < 4; ++i) { kv[uu][i] = kp[i]; vv[uu][i] = vp[i]; }
                if (half == 0) { const f32x4* cp = (const f32x4*)(rope + (size_t)pos * 16);
#pragma unroll
                    for (int i = 0; i < 4; ++i) cs[uu][i] = cp[i]; }
            }
        }
#pragma unroll
        for (int uu = 0; uu < 2; ++uu) {
            LAS h16_t* Ks = (LAS h16_t*)(lds + uu * ATT_UNIT_LDS + LDS_KS);
            LAS h16_t* VT = (LAS h16_t*)(lds + uu * ATT_UNIT_LDS + LDS_VT);
            if (half == 0) {
                float r1[8], r2[8], o1[8], o2[8];
#pragma unroll
                for (int e = 0; e < 4; ++e) { r1[2 * e] = h_lo(kv[uu][0][e]); r1[2 * e + 1] = h_hi(kv[uu][0][e]); r2[2 * e] = h_lo(kv[uu][1][e]); r2[2 * e + 1] = h_hi(kv[uu][1][e]); }
#pragma unroll
                for (int e = 0; e < 8; ++e) { const float c = e < 4 ? cs[uu][0][e & 3] : cs[uu][1][e & 3], sn = e < 4 ? cs[uu][2][e & 3] : cs[uu][3][e & 3]; o1[e] = r1[e] * c - r2[e] * sn; o2[e] = r2[e] * c + r1[e] * sn; }
#pragma unroll
                for (int e = 0; e < 4; ++e) { kv[uu][0][e] = cvt_pk_h(o1[2 * e], o1[2 * e + 1]); kv[uu][1][e] = cvt_pk_h(o2[2 * e], o2[2 * e + 1]); }
            }
#pragma unroll
            for (int i = 0; i < 4; ++i) *(LAS u32x4*)(Ks + kk * KS_STRIDE + half * 32 + 8 * i) = kv[uu][i];
#pragma unroll
            for (int i = 0; i < 4; ++i)
#pragma unroll
                for (int e = 0; e < 4; ++e) {
                    const int d = half * 32 + 8 * i + 2 * e;
                    VT[d * VT_STRIDE + kk] = (h16_t)(vv[uu][i][e] & 0xffffu);
                    VT[(d + 1) * VT_STRIDE + kk] = (h16_t)(vv[uu][i][e] >> 16);
                }
        }
    }
    __syncthreads();
    const int pk = (qi & 3) | (((qi >> 3) & 1) << 2) | (((qi >> 2) & 1) << 3) | (qi & 16);
#pragma unroll 1
    for (int st = 0; st < 4; ++st) {
        const int un = un0 + (st >> 1), blk = un & 15, kvh = (un >> 4) & 3, b = un >> 6, head = kvh * 4 + (wid >> 1);
        const int q0 = ((wid & 1) * 2 + (st & 1)) * 32;
        const int qpos = blk * 128 + q0 + qi;
        h16_t* qp = QO + ((size_t)b * SEQ + qpos) * D + head * HD;
        const float sink = sinks[head];
        LAS h16_t* Ks = (LAS h16_t*)(lds + (st >> 1) * ATT_UNIT_LDS + LDS_KS);
        LAS h16_t* VT = (LAS h16_t*)(lds + (st >> 1) * ATT_UNIT_LDS + LDS_VT);
        QRaw qn;
        {
            const int sn = st < 3 ? st + 1 : st;
            const int un_n = un0 + (sn >> 1), blk_n = un_n & 15, kvh_n = (un_n >> 4) & 3, b_n = un_n >> 6, head_n = kvh_n * 4 + (wid >> 1);
            const int qpos_n = blk_n * 128 + ((wid & 1) * 2 + (sn & 1)) * 32 + qi;
            attn_qload(qn, QO + ((size_t)b_n * SEQ + qpos_n) * D + head_n * HD, rope + (size_t)qpos_n * 16, hi);
        }
        h16x8 qf[4];
        {
            float r1[8], r2[8], o[8];
#pragma unroll
            for (int e = 0; e < 4; ++e) { r1[2 * e] = h_lo(qc.a0[e]); r1[2 * e + 1] = h_hi(qc.a0[e]); r2[2 * e] = h_lo(qc.a1[e]); r2[2 * e + 1] = h_hi(qc.a1[e]); }
#pragma unroll
            for (int e = 0; e < 8; ++e) { const float c = e < 4 ? qc.c0[e & 3] : qc.c1[e & 3], sn = e < 4 ? qc.s0[e & 3] : qc.s1[e & 3];
                o[e] = hi ? (r2[e] * c + r1[e] * sn) : (r1[e] * c - r2[e] * sn); }
            u32x4 w;
#pragma unroll
            for (int e = 0; e < 4; ++e) w[e] = cvt_pk_h(o[2 * e], o[2 * e + 1]);
            qf[0] = __builtin_bit_cast(h16x8, w); qf[1] = qc.q1; qf[2] = qc.q2; qf[3] = qc.q3;
        }
        f32x16 s[5];
#pragma unroll
        for (int j = 0; j < 5; ++j) {
            s[j] = (f32x16){0.f, 0.f, 0.f, 0.f, 0.f, 0.f, 0.f, 0.f, 0.f, 0.f, 0.f, 0.f, 0.f, 0.f, 0.f, 0.f};
#pragma unroll
            for (int ks = 0; ks < 4; ++ks) {
                const h16x8 kf = *(const LAS h16x8*)(Ks + (q0 + 32 * j + pk) * KS_STRIDE + 16 * ks + 8 * hi);
                s[j] = __builtin_amdgcn_mfma_f32_32x32x16_f16(kf, qf[ks], s[j], 0, 0, 0);
            }
        }
        const float NEG = -1e30f;
        const float sinkl = sink * 1.4426950408889634f;
        if (blk == 0) {
#pragma unroll
            for (int j = 0; j < 4; ++j) if (j < 4 - (q0 >> 5)) {
#pragma unroll
                for (int r = 0; r < 16; ++r) s[j][r] = NEG; }
        }
#pragma unroll
        for (int r = 0; r < 16; ++r) { const int kl = (r & 7) + 8 * hi + 16 * (r >> 3); s[0][r] = (kl > qi) ? s[0][r] : NEG; s[4][r] = (kl <= qi) ? s[4][r] : NEG; }
        float mx = sinkl;
#pragma unroll
        for (int j = 0; j < 5; ++j)
#pragma unroll
            for (int r = 0; r < 16; ++r) mx = fmaxf(mx, s[j][r]);
        mx = fmaxf(mx, __shfl_xor(mx, 32));
        float sum = 0.f;
#pragma unroll
        for (int j = 0; j < 5; ++j)
#pragma unroll
            for (int r = 0; r < 16; ++r) { const float p = __builtin_amdgcn_exp2f(s[j][r] - mx); s[j][r] = p; sum += p; }
        sum += __shfl_xor(sum, 32);
        sum += __builtin_amdgcn_exp2f(sinkl - mx);
        const float inv = 1.0f / sum;
        f32x16 o[2];
        o[0] = (f32x16){0.f, 0.f, 0.f, 0.f, 0.f, 0.f, 0.f, 0.f, 0.f, 0.f, 0.f, 0.f, 0.f, 0.f, 0.f, 0.f}; o[1] = o[0];
#pragma unroll
        for (int j = 0; j < 5; ++j)
#pragma unroll
            for (int h = 0; h < 2; ++h) {
                u32x4 w;
#pragma unroll
                for (int e = 0; e < 4; ++e) w[e] = cvt_pk_h(s[j][8 * h + 2 * e], s[j][8 * h + 2 * e + 1]);
                const h16x8 pf = __builtin_bit_cast(h16x8, w);
#pragma unroll
                for (int dt = 0; dt < 2; ++dt) {
                    const h16x8 vf = *(const LAS h16x8*)(VT + (dt * 32 + qi) * VT_STRIDE + q0 + 32 * j + 16 * h + 8 * hi);
                    o[dt] = __builtin_amdgcn_mfma_f32_32x32x16_f16(vf, pf, o[dt], 0, 0, 0);
                }
            }
#pragma unroll
        for (int dt = 0; dt < 2; ++dt)
#pragma unroll
            for (int r = 0; r < 16; ++r) o[dt][r] *= inv;
#pragma unroll
        for (int dt = 0; dt < 2; ++dt)
#pragma unroll
            for (int g4 = 0; g4 < 4; ++g4) {
                u32x2 w; w.x = cvt_pk_h(o[dt][4 * g4], o[dt][4 * g4 + 1]); w.y = cvt_pk_h(o[dt][4 * g4 + 2], o[dt][4 * g4 + 3]);
                *(u32x2*)(qp + 32 * dt + 8 * g4 + 4 * hi) = w;
            }
        qc = qn;
    }
    __syncthreads();
}

__device__ __forceinline__ void conv_item(int it, const h16_t* U, h16_t* CB, const float* cw) {
    const int tid = threadIdx.x, tc = tid >> 7, cgp = tid & 127;
    const int t0 = 64 * it + 16 * tc, c0 = 8 * cgp;
    u32x4 uw[18], bw[16];
    const bool first = (t0 & (SEQ - 1)) == 0;
    uw[0] = (u32x4){0u, 0u, 0u, 0u}; uw[1] = uw[0];
    if (!first) { uw[0] = *(const u32x4*)(U + (size_t)(t0 - 2) * D + c0); uw[1] = *(const u32x4*)(U + (size_t)(t0 - 1) * D + c0); }
#pragma unroll
    for (int i = 0; i < 16; ++i) { const size_t off = (size_t)(t0 + i) * D + c0; uw[i + 2] = *(const u32x4*)(U + off); bw[i] = *(const u32x4*)(CB + off); }
    float w0[8], w1[8], w2[8];
#pragma unroll
    for (int h = 0; h < 2; ++h) { const f32x4 a = *(const f32x4*)(cw + c0 + 4 * h), bq = *(const f32x4*)(cw + D + c0 + 4 * h), c = *(const f32x4*)(cw + 2 * D + c0 + 4 * h);
#pragma unroll
        for (int e = 0; e < 4; ++e) { w0[4 * h + e] = a[e]; w1[4 * h + e] = bq[e]; w2[4 * h + e] = c[e]; } }
#pragma unroll
    for (int i = 0; i < 16; ++i) {
        u32x4 o;
#pragma unroll
        for (int e = 0; e < 4; ++e) {
            const float ylo = h_lo(bw[i][e]) * (w0[2 * e] * h_lo(uw[i][e]) + w1[2 * e] * h_lo(uw[i + 1][e]) + w2[2 * e] * h_lo(uw[i + 2][e]));
            const float yhi = h_hi(bw[i][e]) * (w0[2 * e + 1] * h_hi(uw[i][e]) + w1[2 * e + 1] * h_hi(uw[i + 1][e]) + w2[2 * e + 1] * h_hi(uw[i + 2][e]));
            o[e] = cvt_pk_h(ylo, yhi);
        }
        *(u32x4*)(CB + (size_t)(t0 + i) * D + c0) = o;
    }
}

#define XB_TMO      128
#define XB_XCNT(j)  (256  + 64 * (j))
#define XB_XSUB(j)  (1280 + 64 * (j))
#define XB_XGEN(j)  (2304 + 64 * (j))
#define XB_TOP      3328
#define XB_TOPGEN   3392
#define XCD_BAR_WORDS 3456
#define XB_SPIN_CAP (1u << 18)
__device__ __forceinline__ unsigned xb_ld(unsigned* p)              { return __hip_atomic_load(p, __ATOMIC_RELAXED, __HIP_MEMORY_SCOPE_AGENT); }
__device__ __forceinline__ unsigned xb_add(unsigned* p, unsigned v) { return __hip_atomic_fetch_add(p, v, __ATOMIC_RELAXED, __HIP_MEMORY_SCOPE_AGENT); }
#define XB_SPIN(cond, bar) do { unsigned _sp = 0; while (cond) { __builtin_amdgcn_s_sleep(1); \
    if ((++_sp & 255u) == 0u) { if (xb_ld(&(bar)[XB_TMO])) break; if (_sp > XB_SPIN_CAP) { atomicAdd(&(bar)[XB_TMO], 1u); break; } } } } while (0)
struct XcdBarrier { unsigned* bar; unsigned x; volatile LAS unsigned* st; };
__device__ __forceinline__ XcdBarrier xcd_barrier_post(unsigned* bar, volatile LAS unsigned* st) {
    XcdBarrier b; b.bar = bar; b.x = xb_xcc_id(); b.st = st;
    if (threadIdx.x == 0) (void)xb_add(&bar[XB_XCNT(b.x)], 1u);
    return b;
}
__device__ __forceinline__ void xcd_barrier_complete(unsigned* bar, unsigned x, unsigned& nloc, unsigned& nx) {
    const unsigned G = gridDim.x * gridDim.y * gridDim.z;
    unsigned sum, cnt, mine, sp = 0u;
    for (;;) {
        sum = 0u; cnt = 0u; mine = 0u;
#pragma unroll
        for (unsigned j = 0; j < 16; ++j) { const unsigned c = xb_ld(&bar[XB_XCNT(j)]); sum += c; cnt += (c > 0u) ? 1u : 0u; mine = (j == x) ? c : mine; }
        if (sum == G) break;
        __builtin_amdgcn_s_sleep(1);
        if ((++sp & 255u) == 0u) { if (xb_ld(&bar[XB_TMO])) break; if (sp > XB_SPIN_CAP) { atomicAdd(&bar[XB_TMO], 1u); break; } }
    }
    nloc = mine > 0u ? mine : 1u; nx = cnt > 0u ? cnt : 1u;
}
__device__ __forceinline__ void xcd_barrier(const XcdBarrier& b) {
    asm volatile("s_waitcnt vmcnt(0)" ::: "memory");
    __syncthreads();
    if (threadIdx.x == 0) {
        unsigned* bar = b.bar;
        __builtin_amdgcn_s_waitcnt(0);
        unsigned nloc = b.st[0], nx = b.st[1];
        if (nloc == 0u) { xcd_barrier_complete(bar, b.x, nloc, nx); b.st[0] = nloc; b.st[1] = nx; }
        const unsigned old = xb_add(&bar[XB_XSUB(b.x)], 1u);
        const unsigned gen = old / nloc;
        if (old + 1u == (gen + 1u) * nloc) {
            __builtin_amdgcn_fence(__ATOMIC_RELEASE, "agent");
            asm volatile("s_waitcnt vmcnt(0)" ::: "memory");
            const unsigned og = xb_add(&bar[XB_TOP], 1u);
            const unsigned tg = og / nx;
            if (og + 1u == (tg + 1u) * nx) xb_add(&bar[XB_TOPGEN], 1u);
            else XB_SPIN(xb_ld(&bar[XB_TOPGEN]) == tg, bar);
            __builtin_amdgcn_fence(__ATOMIC_ACQUIRE, "agent");
            xb_add(&bar[XB_XGEN(b.x)], 1u);
            asm volatile("s_waitcnt vmcnt(0)" ::: "memory");
        } else {
            XB_SPIN(xb_ld(&bar[XB_XGEN(b.x)]) == gen, bar);
            __builtin_amdgcn_fence(__ATOMIC_ACQUIRE, "agent");
            asm volatile("s_waitcnt vmcnt(0)" ::: "memory");
        }
    }
    __syncthreads();
}

struct Args { const float* in[12]; float* out; unsigned char* ws; float inv_freq[8]; };

template <int PH> __device__ __forceinline__ void run_phase(const Args& a, LAS unsigned char* lds) {
    const int tid = threadIdx.x, lane = tid & 63, wave = __builtin_amdgcn_readfirstlane(tid >> 6);
    const int G = gridDim.x, bx = blockIdx.x;
    const int vcu = (G % 8 == 0) ? (bx % 8) * (G / 8) + bx / 8 : bx;
    unsigned char* ws = a.ws;
    const float* x = a.in[0]; const float* g_mix = a.in[1]; const float* w_in = a.in[2]; const float* conv_w = a.in[3]; const float* sinks = a.in[4];
    const float* w_conv_out = a.in[5]; const float* w_attn_out = a.in[6]; const float* w_o = a.in[7]; const float* g_ffn = a.in[8];
    const float* w_gate_up = a.in[9]; const float* w_down = a.in[10]; const float* g_final = a.in[11];
    float* rope = (float*)(ws + WS_ROPE); float* rp1 = (float*)(ws + WS_RP1); float* rp2 = (float*)(ws + WS_RP2);
    h16_t* Win_t = (h16_t*)(ws + WS_WIN); h16_t* Wc_t = (h16_t*)(ws + WS_WC); h16_t* Wa_t = (h16_t*)(ws + WS_WA); h16_t* Wo_t = (h16_t*)(ws + WS_WO);
    h16_t* Wgu_t = (h16_t*)(ws + WS_WGU); h16_t* Wd_t = (h16_t*)(ws + WS_WD);
    h16_t* H0 = (h16_t*)(ws + WS_H0); h16_t* Ub = (h16_t*)(ws + WS_U); h16_t* CBb = (h16_t*)(ws + WS_CB); h16_t* Qb = (h16_t*)(ws + WS_Q);
    h16_t* Kb = (h16_t*)(ws + WS_K); h16_t* Vb = (h16_t*)(ws + WS_V); h16_t* GCb = (h16_t*)(ws + WS_GC); h16_t* GAb = (h16_t*)(ws + WS_GA);
    h16_t* ACTb = (h16_t*)(ws + WS_ACT); h16_t* X1B = Qb;
    float* out = a.out;

    if constexpr (PH == 0) {
        LAS unsigned* scr = (LAS unsigned*)(lds + wave * 16384);
        const int gw = vcu * NWAVES + wave, NGW = G * NWAVES;
        constexpr int I_IN = (D / 64) * (NIN / 32);
        constexpr int I_SQ0 = (D / 64) * (D / 32);
        constexpr int I_GU0 = (D / 64) * (2 * DFF / 32), I_DN0 = (DFF / 64) * (D / 32);
        for (int it = gw; it < I_IN + 3 * I_SQ0 + I_GU0 + I_DN0; it += NGW) {
            int r = it;
            if (r < I_IN) { const int nb = r % (NIN / 32), kb = r / (NIN / 32); p0_transpose_item(w_in, D, NIN, Win_t, map_win(32 * nb), 32 * nb, 64 * kb, nullptr, scr, lane); continue; } r -= I_IN;
            if (r < 3 * I_SQ0) { const float* Wsrc = r < I_SQ0 ? w_conv_out : (r < 2 * I_SQ0 ? w_attn_out : w_o); h16_t* Wdst = r < I_SQ0 ? Wc_t : (r < 2 * I_SQ0 ? Wa_t : Wo_t); r %= I_SQ0;
                const int nb = r % (D / 32), kb = r / (D / 32); p0_transpose_item(Wsrc, D, D, Wdst, 32 * nb, 32 * nb, 64 * kb, nullptr, scr, lane); continue; } r -= 3 * I_SQ0;
            if (r < I_GU0) { const int nb = r % (2 * DFF / 32), kb = r / (2 * DFF / 32); p0_transpose_item(w_gate_up, D, 2 * DFF, Wgu_t, map_wgu(32 * nb), 32 * nb, 64 * kb, g_ffn, scr, lane); continue; } r -= I_GU0;
            { const int nb = r % (D / 32), kb = r / (D / 32); p0_transpose_item(w_down, DFF, D, Wd_t, 32 * nb, 32 * nb, 64 * kb, nullptr, scr, lane); }
        }
        {
            f32x4 gq[4];
#pragma unroll
            for (int j = 0; j < 4; ++j) gq[j] = ((const f32x4*)g_mix)[lane + 64 * j];
            for (int m = gw; m < M; m += 4 * NGW) {
                f32x4 xv[4][4];
#pragma unroll
                for (int r = 0; r < 4; ++r) { const f32x4* xr = (const f32x4*)(x + (size_t)(m + r * NGW) * D) + lane;
#pragma unroll
                    for (int j = 0; j < 4; ++j) xv[r][j] = __builtin_nontemporal_load(xr + 64 * j); }
#pragma unroll
                for (int r = 0; r < 4; ++r) {
                    float ss = 0.f;
#pragma unroll
                    for (int j = 0; j < 4; ++j) ss += (xv[r][j][0] * xv[r][j][0] + xv[r][j][1] * xv[r][j][1]) + (xv[r][j][2] * xv[r][j][2] + xv[r][j][3] * xv[r][j][3]);
                    const float rs = 1.0f / sqrtf(wave_sum(ss) * (1.0f / D) + EPS);
                    u32x2* o8 = (u32x2*)(H0 + (size_t)(m + r * NGW) * D) + lane;
#pragma unroll
                    for (int j = 0; j < 4; ++j) { u32x2 w; w.x = cvt_pk_h(xv[r][j][0] * rs * gq[j][0], xv[r][j][1] * rs * gq[j][1]); w.y = cvt_pk_h(xv[r][j][2] * rs * gq[j][2], xv[r][j][3] * rs * gq[j][3]); o8[64 * j] = w; }
                }
            }
        }
        if (tid == 0) __hip_atomic_fetch_or((unsigned*)(ws + WS_GRP) + 64 * (bx & 7) + 32, 1u << xb_xcc_id(), __ATOMIC_RELAXED, __HIP_MEMORY_SCOPE_AGENT);
        for (int i = bx * NTHREADS + tid; i < SEQ * 8; i += G * NTHREADS) {
            const int pos = i >> 3, f = i & 7;
            const float ang = (float)pos * a.inv_freq[f];
            double rev = (double)ang * 0.15915494309189535; rev -= floor(rev);
            const float fr = (float)rev;
            rope[pos * 16 + f] = __builtin_amdgcn_cosf(fr); rope[pos * 16 + 8 + f] = __builtin_amdgcn_sinf(fr);
        }
    }

    const bool heavy = bx < 128; const int pj = (bx >> 3) & 15, my_pm = __builtin_amdgcn_readfirstlane(8 * (bx & 7) + (heavy ? 4 : 0) + (pj >> 2)), my_pn = __builtin_amdgcn_readfirstlane(pj & 3);
    unsigned* const r6 = (unsigned*)(ws + WS_R6); unsigned* const r7 = (unsigned*)(ws + WS_R7); unsigned* const pbar = (unsigned*)(ws + WS_PB) + 64 * my_pm;
    if constexpr (PH == 1) {
        unsigned* const grp = (unsigned*)(ws + WS_GRP) + 64 * (bx & 7);
        const unsigned gm = __hip_atomic_load(grp + 32, __ATOMIC_RELAXED, __HIP_MEMORY_SCOPE_AGENT); const bool samex = (gm & (gm - 1u)) == 0u;
        pg8::Gemm g{H0, Win_t, H0, Win_t, D};
        pg8::ProjOrder S{bx, grp, grp + 16, samex};
        pg8::EpiProj E{CBb, Ub, Qb, Kb, Vb, GCb, GAb};
        pg8::gemm_phase<pg8::EpiProj, pg8::ProjOrder, true>(lds, g, S, E);
        if (heavy) block_wait2(grp, 32u * NWAVES, grp + 16, 16u * NWAVES);
        else block_wait(grp, 32u * NWAVES);
    }

    if constexpr (PH == 2) {
        conv_item(4 * my_pm + my_pn, Ub, CBb, conv_w);
        attn_pair(lds, (((my_pm >> 3) * 4 + my_pn) << 4) + 2 * (my_pm & 7), Qb, Kb, Vb, rope, sinks);
        { const unsigned gm_ = (unsigned)__builtin_amdgcn_readfirstlane((int)__hip_atomic_load((unsigned*)(ws + WS_GRP) + 64 * (bx & 7) + 32, __ATOMIC_RELAXED, __HIP_MEMORY_SCOPE_AGENT)); group_barrier(pbar, 4u, (gm_ & (gm_ - 1u)) == 0u); }
    }

    if constexpr (PH == 3) {
        pg8::Gemm g{CBb, Wc_t, Qb, Wa_t, D}; pg8::DualOrder S; S.so.init(M, D, G, (my_pm >> 3) + 8 * (my_pm & 7) + 64 * my_pn);
        pg8::EpiGated E{GCb, GAb};
        pg8::gemm_phase<pg8::EpiGated, pg8::DualOrder, true>(lds, g, S, E);
        { const unsigned gm_ = (unsigned)__builtin_amdgcn_readfirstlane((int)__hip_atomic_load((unsigned*)(ws + WS_GRP) + 64 * (bx & 7) + 32, __ATOMIC_RELAXED, __HIP_MEMORY_SCOPE_AGENT)); group_barrier(pbar, 8u, (gm_ & (gm_ - 1u)) == 0u); }
    }

    if constexpr (PH == 4) {
        pg8::Gemm g{GAb, Wo_t, GAb, Wo_t, D}; pg8::StaticOrder S; S.init(M, D, G, (my_pm >> 3) + 8 * (my_pm & 7) + 64 * my_pn);
        pg8::EpiResid E{x, X1B, rp1};
        pg8::gemm_phase<pg8::EpiResid, pg8::StaticOrder, false>(lds, g, S, E);
        {
            unsigned* const grp = (unsigned*)(ws + WS_GRP) + 64 * (bx & 7);
            const unsigned gm = __hip_atomic_load(grp + 32, __ATOMIC_RELAXED, __HIP_MEMORY_SCOPE_AGENT);
            wave_arrive(grp + (heavy ? 48 : 40), (gm & (gm - 1u)) == 0u, lane);
        }
    }

    if constexpr (PH == 5) {
        unsigned* const grp = (unsigned*)(ws + WS_GRP) + 64 * (bx & 7);
        if (!heavy) block_wait2(grp + 16, 16u * NWAVES, grp + 40, 16u * NWAVES);
        else block_wait(grp + 48, 16u * NWAVES);
        pg8::Gemm g{X1B, Wgu_t, X1B, Wgu_t, D}; pg8::SwiOrder S{bx, grp + 48, 16u * NWAVES};
        pg8::EpiSwiGLU E{ws, rp1};
        pg8::gemm_phase<pg8::EpiSwiGLU, pg8::SwiOrder, true>(lds, g, S, E);
    }

    if constexpr (PH == 6) {
        pg8::Gemm g{(const h16_t*)ws, Wd_t, (const h16_t*)ws, Wd_t, DFF}; pg8::StaticOrder S; S.init(M, D, G, bx, 1);
        pg8::EpiFinal E{X1B, out, g_final, rp2, (unsigned*)(ws + WS_PCNT)};
        pg8::gemm_phase<pg8::EpiFinal, pg8::StaticOrder, false>(lds, g, S, E);
    }

    if constexpr (PH == 7) {
        const int gw = vcu * NWAVES + wave, NGW = G * NWAVES;
        for (int m = gw; m < M; m += NGW) {
            const f32x4 p = *(const f32x4*)(rp2 + (size_t)m * 4);
            const float rs = 1.0f / sqrtf(((p[0] + p[1]) + (p[2] + p[3])) * (1.0f / D) + EPS);
            f32x4* xr = (f32x4*)(out + (size_t)m * D) + lane;
#pragma unroll
            for (int j = 0; j < 4; ++j) { const f32x4 gq = ((const f32x4*)g_final)[lane + 64 * j]; f32x4 v = xr[64 * j]; v = v * rs * gq; xr[64 * j] = v; }
        }
    }
}

__global__ void __launch_bounds__(NTHREADS, 2) fwd_megakernel(Args a) {
    extern __shared__ __attribute__((aligned(16))) unsigned char lds_raw[];
    LAS unsigned char* lds = (LAS unsigned char*)lds_raw;
    if (a.ws == nullptr) { cg::grid_group grid = cg::this_grid(); grid.sync(); }
    volatile LAS unsigned* st = (volatile LAS unsigned*)(lds + LDS_BAR_ST);
    if (threadIdx.x < 2) st[threadIdx.x] = 0u;
    __syncthreads();
    const XcdBarrier bar = xcd_barrier_post((unsigned*)(a.ws + WS_BAR), st);
    run_phase<0>(a, lds); xcd_barrier(bar);
    run_phase<1>(a, lds);
    run_phase<2>(a, lds);
    run_phase<3>(a, lds);
    run_phase<4>(a, lds);
    run_phase<5>(a, lds);
    { const unsigned gm_ = __hip_atomic_load((unsigned*)(a.ws + WS_GRP) + 64 * (blockIdx.x & 7) + 32, __ATOMIC_RELAXED, __HIP_MEMORY_SCOPE_AGENT);
      group_barrier((unsigned*)(a.ws + WS_GRP + 2048) + 64 * (blockIdx.x & 7), 32u, (gm_ & (gm_ - 1u)) == 0u); }
    run_phase<6>(a, lds);
}

extern "C" void kernel_launch(void* const* d_in, const int* in_sizes, int n_in, void* d_out, int out_size, void* d_ws, size_t ws_size, hipStream_t stream) {
    static int grid = 0;
    if (grid == 0) {
        if (n_in != 12 || in_sizes[0] != M * D || out_size != M * D || ws_size < WS_END) { fprintf(stderr, "kernel_launch: unexpected shapes (n_in %d, in0 %d, out %d, ws %zu)\n", n_in, n_in > 0 ? in_sizes[0] : -1, out_size, ws_size); grid = -1; return; }
        int dev = 0, cus = 0, per_cu = 0;
        if (hipGetDevice(&dev) != hipSuccess || hipDeviceGetAttribute(&cus, hipDeviceAttributeMultiprocessorCount, dev) != hipSuccess) { grid = -1; return; }
        if (hipFuncSetAttribute((const void*)fwd_megakernel, hipFuncAttributeMaxDynamicSharedMemorySize, LDS_BYTES) != hipSuccess) { fprintf(stderr, "kernel_launch: hipFuncSetAttribute failed\n"); grid = -1; return; }
        if (hipOccupancyMaxActiveBlocksPerMultiprocessor(&per_cu, (const void*)fwd_megakernel, NTHREADS, LDS_BYTES) != hipSuccess || per_cu < 1) { fprintf(stderr, "kernel_launch: occupancy query says %d blocks per CU\n", per_cu); (void)hipGetLastError(); grid = -1; return; }
        if (cus < 256) { fprintf(stderr, "kernel_launch: %d CUs < 256\n", cus); grid = -1; return; }
        grid = 256;
    }
    if (grid < 0) return;
    Args a{};
    for (int i = 0; i < 12; ++i) a.in[i] = (const float*)d_in[i];
    a.out = (float*)d_out; a.ws = (unsigned char*)d_ws;
    for (int i = 0; i < 8; ++i) a.inv_freq[i] = powf(500000.0f, -(float)(2 * i) / 16.0f);
    if (hipMemsetAsync((char*)d_ws + WS_BAR, 0, 65536, stream) != hipSuccess) { fprintf(stderr, "kernel_launch: memset failed\n"); return; }
    void* args[] = {&a};
    hipError_t e = hipLaunchCooperativeKernel((const void*)fwd_megakernel, dim3(grid), dim3(NTHREADS), args, LDS_BYTES, stream);
    if (e != hipSuccess) fprintf(stderr, "kernel_launch: cooperative launch failed: %s\n", hipGetErrorString(e));
}
```

```cpp
#include <hip/hip_runtime.h>
#include <hip/hip_cooperative_groups.h>
#include <cstdio>
#include <cstdint>
#include <cmath>
namespace cg = cooperative_groups;

#define LAS __attribute__((address_space(3)))
typedef unsigned short h16_t;
typedef _Float16 h16x8 __attribute__((ext_vector_type(8)));
typedef _Float16 h16x2 __attribute__((ext_vector_type(2)));
typedef float f32x4 __attribute__((ext_vector_type(4)));
typedef float f32x16 __attribute__((ext_vector_type(16)));
typedef unsigned u32x4 __attribute__((ext_vector_type(4)));
typedef unsigned u32x2 __attribute__((ext_vector_type(2)));

constexpr int D = 1024, BATCH = 8, SEQ = 2048, M = BATCH * SEQ;
constexpr int NH = 16, NKV = 4, HD = 64, DKV = NKV * HD;
constexpr int DFF = 2816, NIN = 6656;
constexpr float EPS = 1e-5f;
constexpr int NWAVES = 8, NTHREADS = 512;

constexpr size_t MiB = 1u << 20;
constexpr size_t WS_ROPE = 0;
constexpr size_t WS_RP1 = 256 * 1024;
constexpr size_t WS_RP2 = 512 * 1024;
constexpr size_t WS_WIN = 1 * MiB;
constexpr size_t WS_WC = 14 * MiB, WS_WA = 16 * MiB, WS_WO = 18 * MiB;
constexpr size_t WS_WGU = 20 * MiB;
constexpr size_t WS_WD = 31 * MiB;
constexpr size_t WS_H0 = 40 * MiB;
constexpr size_t WS_U = 72 * MiB;
constexpr size_t WS_CB = 104 * MiB;
constexpr size_t WS_Q = 136 * MiB;
constexpr size_t WS_K = 168 * MiB, WS_V = 176 * MiB;
constexpr size_t WS_GC = 184 * MiB;
constexpr size_t WS_GA = 216 * MiB;
constexpr size_t WS_ACT = 40 * MiB;
constexpr size_t WS_END = 248 * MiB;

constexpr size_t WS_BAR = 832 * 1024;
constexpr size_t WS_PCNT = WS_BAR + 16384;
constexpr size_t WS_R6 = WS_BAR + 32768, WS_R7 = WS_R6 + 256, WS_PB = WS_R6 + 1024, WS_RX = WS_PB + 16384;
constexpr size_t WS_GRP = WS_BAR + 57344;
constexpr int LDS_BAR_ST = 147456 - 16;
constexpr int LDS_BYTES = 147456;

__device__ __forceinline__ unsigned cvt_pk_h(float lo, float hi) { h16x2 v; v.x = (_Float16)lo; v.y = (_Float16)hi; return __builtin_bit_cast(unsigned, v); }
__device__ __forceinline__ float h_lo(unsigned w) { return (float)__builtin_bit_cast(h16x2, w).x; }
__device__ __forceinline__ float h_hi(unsigned w) { return (float)__builtin_bit_cast(h16x2, w).y; }
__device__ __forceinline__ float sigmoidf_(float x) { return __builtin_amdgcn_rcpf(1.0f + __builtin_amdgcn_exp2f(-1.4426950408889634f * x)); }
__device__ __forceinline__ float wave_sum(float v) {
#pragma unroll
    for (int o = 1; o < 64; o <<= 1) v += __shfl_xor(v, o);
    return v;
}
#define LDS_WAIT() asm volatile("s_waitcnt lgkmcnt(0)" ::: "memory")


#define SYNC_SPIN_CAP (1u << 22)
__device__ __forceinline__ unsigned xb_xcc_id() { return (unsigned)__builtin_amdgcn_s_getreg((3 << 11) | 20) & 0xFu; }
__device__ __forceinline__ void wave_arrive(unsigned* cnt, bool samex, int lane) {
    asm volatile("s_waitcnt vmcnt(0)" ::: "memory");
    if (lane == 0) {
        if (!samex) { __builtin_amdgcn_fence(__ATOMIC_RELEASE, "agent"); asm volatile("s_waitcnt vmcnt(0)" ::: "memory"); }
        __hip_atomic_fetch_add(cnt, 1u, __ATOMIC_RELAXED, __HIP_MEMORY_SCOPE_AGENT);
    }
}
__device__ __forceinline__ void block_wait(unsigned* cnt, unsigned target) {
    if (threadIdx.x == 0) {
        unsigned sp = 0;
        while (__hip_atomic_load(cnt, __ATOMIC_RELAXED, __HIP_MEMORY_SCOPE_AGENT) < target) { __builtin_amdgcn_s_sleep(2); if (++sp > SYNC_SPIN_CAP) break; }
        __builtin_amdgcn_fence(__ATOMIC_ACQUIRE, "agent");
        asm volatile("s_waitcnt vmcnt(0)" ::: "memory");
    }
    __syncthreads();
}
__device__ __forceinline__ void block_wait2(unsigned* cntA, unsigned tgtA, unsigned* cntB, unsigned tgtB) {
    if (threadIdx.x == 0) {
        unsigned sp = 0;
        while (__hip_atomic_load(cntA, __ATOMIC_RELAXED, __HIP_MEMORY_SCOPE_AGENT) < tgtA || __hip_atomic_load(cntB, __ATOMIC_RELAXED, __HIP_MEMORY_SCOPE_AGENT) < tgtB) { __builtin_amdgcn_s_sleep(2); if (++sp > SYNC_SPIN_CAP) break; }
        __builtin_amdgcn_fence(__ATOMIC_ACQUIRE, "agent");
        asm volatile("s_waitcnt vmcnt(0)" ::: "memory");
    }
    __syncthreads();
}
__device__ __forceinline__ void group_barrier(unsigned* cnt, unsigned target, bool samex) {
    asm volatile("s_waitcnt vmcnt(0)" ::: "memory");
    __syncthreads();
    if (threadIdx.x == 0) {
        if (!samex) { __builtin_amdgcn_fence(__ATOMIC_RELEASE, "agent"); asm volatile("s_waitcnt vmcnt(0)" ::: "memory"); }
        __hip_atomic_fetch_add(cnt, 1u, __ATOMIC_RELAXED, __HIP_MEMORY_SCOPE_AGENT);
        unsigned sp = 0;
        while (__hip_atomic_load(cnt, __ATOMIC_RELAXED, __HIP_MEMORY_SCOPE_AGENT) < target) { __builtin_amdgcn_s_sleep(1); if (++sp > SYNC_SPIN_CAP) break; }
        __builtin_amdgcn_fence(__ATOMIC_ACQUIRE, "agent");
        asm volatile("s_waitcnt vmcnt(0)" ::: "memory");
    }
    __syncthreads();
}
__device__ __forceinline__ void group_barrier2(unsigned* cnt, unsigned target, unsigned* cntB, unsigned tgtB, bool samex) {
    asm volatile("s_waitcnt vmcnt(0)" ::: "memory");
    __syncthreads();
    if (threadIdx.x == 0) {
        if (!samex) { __builtin_amdgcn_fence(__ATOMIC_RELEASE, "agent"); asm volatile("s_waitcnt vmcnt(0)" ::: "memory"); }
        __hip_atomic_fetch_add(cnt, 1u, __ATOMIC_RELAXED, __HIP_MEMORY_SCOPE_AGENT);
        unsigned sp = 0;
        while (__hip_atomic_load(cnt, __ATOMIC_RELAXED, __HIP_MEMORY_SCOPE_AGENT) < target || __hip_atomic_load(cntB, __ATOMIC_RELAXED, __HIP_MEMORY_SCOPE_AGENT) < tgtB) { __builtin_amdgcn_s_sleep(1); if (++sp > SYNC_SPIN_CAP) break; }
        __builtin_amdgcn_fence(__ATOMIC_ACQUIRE, "agent");
        asm volatile("s_waitcnt vmcnt(0)" ::: "memory");
    }
    __syncthreads();
}
__device__ __forceinline__ void panel_barrier(unsigned* cnt, unsigned target, unsigned xcc) {
    asm volatile("s_waitcnt vmcnt(0)" ::: "memory");
    __syncthreads();
    if (threadIdx.x == 0) {
        __hip_atomic_fetch_or(cnt + 1, 1u << xcc, __ATOMIC_RELAXED, __HIP_MEMORY_SCOPE_AGENT);
        asm volatile("s_waitcnt vmcnt(0)" ::: "memory");
        __hip_atomic_fetch_add(cnt, 1u, __ATOMIC_RELAXED, __HIP_MEMORY_SCOPE_AGENT);
        unsigned sp = 0;
        while (__hip_atomic_load(cnt, __ATOMIC_RELAXED, __HIP_MEMORY_SCOPE_AGENT) < target) { __builtin_amdgcn_s_sleep(1); if (++sp > SYNC_SPIN_CAP) break; }
        const unsigned mask = __hip_atomic_load(cnt + 1, __ATOMIC_RELAXED, __HIP_MEMORY_SCOPE_AGENT);
        if (mask & (mask - 1u)) {
            __builtin_amdgcn_fence(__ATOMIC_RELEASE, "agent"); asm volatile("s_waitcnt vmcnt(0)" ::: "memory");
            __hip_atomic_fetch_add(cnt + 2, 1u, __ATOMIC_RELAXED, __HIP_MEMORY_SCOPE_AGENT);
            sp = 0;
            while (__hip_atomic_load(cnt + 2, __ATOMIC_RELAXED, __HIP_MEMORY_SCOPE_AGENT) < target) { __builtin_amdgcn_s_sleep(1); if (++sp > SYNC_SPIN_CAP) break; }
        }
        __builtin_amdgcn_fence(__ATOMIC_ACQUIRE, "agent");
        asm volatile("s_waitcnt vmcnt(0)" ::: "memory");
    }
    __syncthreads();
}

__host__ __device__ __forceinline__ size_t act_slot(int pm) {
    const int g = pm >> 3, l = pm & 7, p = l & 3;
    return ((size_t)(40 + 32 * p + 48 * ((p >> 1) & p)) + 4 * (size_t)g + 2 * (size_t)(l >> 2)) * MiB;
}

namespace pg8 {
constexpr int BM = 256, BK = 64, HALF = 128, HTB = HALF * BK * 2, STAGE_BYTES = 8 * HTB, NXCD = 8, WGM = 8;
__host__ __device__ __forceinline__ int lds_byte(int r, int c) { const int st = (r >> 4) * 2 + (c >> 5), rr = r & 15, cc = c & 31, ob = rr * 64 + cc * 2; return st * 1024 + (ob ^ (((ob >> 9) & 1) << 5)); }
__host__ __device__ __forceinline__ void stage_rc(int b, int& R, int& C) { const int st = b / 1024, sb = b % 1024, swz = sb ^ (((sb >> 9) & 1) << 5); R = (st >> 1) * 16 + swz / 64; C = (st & 1) * 32 + (swz % 64) / 2; }
__host__ __device__ __forceinline__ int perm32(int rho) { const int n = rho >> 4, i = rho & 15; return 8 * (i >> 2) + 4 * n + (i & 3); }

struct Unit { int pm, pn, z; long long aoff; };
struct Gemm { const h16_t* A0; const h16_t* B0; const h16_t* A1; const h16_t* B1; int K; };

struct StaticOrder {
    int nM, nN, nwg, G, c, act;
    __device__ void init(int M_, int N_, int G_, int c_, int act_ = 0) { nM = M_ / BM; nN = N_ / BM; nwg = nM * nN; G = G_; c = c_; act = act_; }
    __device__ bool next(int i, Unit& u) const {
        const long L = (long)i * G + c; if (L >= nwg) return false;
        int wgid = (int)L; { const int q = nwg / NXCD, r = nwg % NXCD, xcd = wgid % NXCD, off = wgid / NXCD; wgid = (xcd < r ? xcd * (q + 1) : r * (q + 1) + (xcd - r) * q) + off; }
        const int nig = WGM * nN, gid = wgid / nig, fm = gid * WGM, gsz = (nM - fm) < WGM ? (nM - fm) : WGM;
        u.pm = fm + ((wgid % nig) % gsz); u.pn = (wgid % nig) / gsz; u.z = 0; u.aoff = act ? (long long)act_slot(u.pm) : -1; return true;
    }
    __device__ __forceinline__ void done(int, int) const {}
};
struct DualOrder {
    StaticOrder so;
    __device__ bool next(int i, Unit& u) const { if (i >= 2) return false; if (!so.next(0, u)) return false; u.z = i; return true; }
    __device__ __forceinline__ void done(int, int) const {}
};
struct ProjOrder {
    int c; unsigned* r6; unsigned* r7; bool samex;
    __device__ bool next(int i, Unit& u) const {
        const int idx = 32 * i + (c >> 3); if (idx >= 208) return false;
        int pm, pn;
        if (idx < 176) { pm = idx & 7; pn = idx >> 3; } else if (idx < 192) { const int j = idx - 176; pm = j & 3; pn = 22 + (j >> 2); } else { const int j = idx - 192; pm = 4 + (j & 3); pn = 22 + (j >> 2); }
        u.pm = 8 * (c & 7) + pm; u.pn = pn; u.z = 0; u.aoff = -1; return true;
    }
    __device__ __forceinline__ void done(int ui, int lane) const { if (ui == 5) wave_arrive(r6, samex, lane); if (ui == 6) wave_arrive(r7, samex, lane); }
};
struct SwiOrder {
    int c; unsigned* l4; unsigned tgt;
    __device__ __forceinline__ bool next(int i, Unit& u) const {
        const int idx = 16 * i + ((c >> 3) & 15); int pm, pn;
        if (c >= 128) {
            if (idx >= 96) return false;
            if (idx < 88) { pm = idx & 3; pn = idx >> 2; }
            else { const int k = idx - 88; pm = 4 + (k & 3); pn = 20 + (k >> 2);
                unsigned sp = 0;
                while (__hip_atomic_load(l4, __ATOMIC_RELAXED, __HIP_MEMORY_SCOPE_AGENT) < tgt) { __builtin_amdgcn_s_sleep(2); if (++sp > SYNC_SPIN_CAP) break; }
                __builtin_amdgcn_fence(__ATOMIC_ACQUIRE, "agent"); }
        } else { if (idx >= 80) return false; pm = 4 + (idx & 3); pn = idx >> 2; }
        u.pm = 8 * (c & 7) + pm; u.pn = pn; u.z = 0; u.aoff = -1; return true;
    }
    __device__ __forceinline__ void done(int, int) const {}
};
__device__ __forceinline__ void panel_of(int c, int& pm, int& pn) { const int pj = (c >> 3) & 15; pm = 8 * (c & 7) + ((c < 128) ? 4 : 0) + (pj >> 2); pn = pj & 3; }
struct PanelDual {
    int c, n;
    __device__ bool next(int i, Unit& u) const { if (i >= n) return false; panel_of(c, u.pm, u.pn); u.z = i; u.aoff = -1; return true; }
    __device__ __forceinline__ void done(int, int) const {}
};
struct PanelOne {
    int c, n;
    __device__ bool next(int i, Unit& u) const { if (i >= n) return false; panel_of(c, u.pm, u.pn); u.z = 0; u.aoff = -1; return true; }
    __device__ __forceinline__ void done(int, int) const {}
};

template <class Epi, class Sched, bool ALIGN_EPI>
__device__ __forceinline__ void gemm_phase(LAS unsigned char* lds, const Gemm g, const Sched& S, const Epi& E) {
    const int tid = threadIdx.x, wid = __builtin_amdgcn_readfirstlane(tid >> 6), lane = tid & 63, wr = wid >> 2, wc = wid & 3, fr = lane & 15, fq = lane >> 4;
    const int K = g.K, nt = K / BK;
    unsigned voffA[2], voffB[2];
#pragma unroll
    for (int i = 0; i < 2; ++i) { int R, C; stage_rc(tid * 16 + i * 8192, R, C); const int Rb = (R & ~31) + perm32(R & 31);
        voffA[i] = (unsigned)(R * K + C) * 2u; voffB[i] = (unsigned)(Rb * K + C) * 2u; }
    const size_t kstep = (size_t)(BK * 2);
    const size_t hstep = (size_t)HALF * K * 2;
    const size_t tstep = 2 * hstep;
    const unsigned ldsw = (unsigned)wid * 1024u;
    const int aoff = lds_byte(wr * 64 + fr, fq * 8), boff = lds_byte(wc * 32 + fr, fq * 8);
#define PG8_SA(b, h) (((b) * 2 + (h)) * HTB)
#define PG8_SB(b, h) ((4 + (b) * 2 + (h)) * HTB)
#define PG8_STAGE(bufoff, gbase, voff) do { _Pragma("unroll") for (int _i = 0; _i < 2; ++_i) \
        __builtin_amdgcn_global_load_lds((const unsigned*)((const char*)(gbase) + (voff)[_i]), (LAS unsigned*)(lds + (bufoff) + ldsw + _i * 8192), 16, 0, 0); } while (0)
#define PG8_LDA(dst, b, h) do { _Pragma("unroll") for (int m = 0; m < 4; ++m) _Pragma("unroll") for (int k = 0; k < 2; ++k) dst[m][k] = *(const LAS h16x8*)(lds + PG8_SA(b, h) + aoff + m * 2048 + k * 1024); } while (0)
#define PG8_LDB(dst, b, h) do { _Pragma("unroll") for (int n = 0; n < 2; ++n) _Pragma("unroll") for (int k = 0; k < 2; ++k) dst[n][k] = *(const LAS h16x8*)(lds + PG8_SB(b, h) + boff + n * 2048 + k * 1024); } while (0)
#define PG8_MMA(ai, bj, At, Bt) do { __builtin_amdgcn_s_setprio(1); _Pragma("unroll") for (int m = 0; m < 4; ++m) _Pragma("unroll") for (int n = 0; n < 2; ++n) _Pragma("unroll") for (int k = 0; k < 2; ++k) \
        acc[ai][bj][m][n] = __builtin_amdgcn_mfma_f32_16x16x32_f16(Bt[n][k], At[m][k], acc[ai][bj][m][n], 0, 0, 0); __builtin_amdgcn_s_setprio(0); } while (0)
#define PG8_WAIT_V(n) asm volatile("s_waitcnt vmcnt(" #n ")" ::: "memory")
#define PG8_WAIT_L(n) asm volatile("s_waitcnt lgkmcnt(" #n ")" ::: "memory")
#define PG8_BAR __builtin_amdgcn_s_barrier()
#define PG8_SCHED __builtin_amdgcn_sched_barrier(0)
    Unit cur, nxt; int ui = 0;
    if (!S.next(0, cur)) return;
    f32x4 acc[2][2][4][2]; typename Epi::Tmp itmp;
    E.init_acc(acc, itmp, cur, wr, wc, fr, fq);
    h16x8 At[4][2], B0[2][2], B1[2][2];
    const char* cA = cur.aoff >= 0 ? (const char*)g.A0 + cur.aoff : (const char*)(cur.z ? g.A1 : g.A0) + (size_t)cur.pm * tstep; const char* cB = (const char*)(cur.z ? g.B1 : g.B0) + (size_t)cur.pn * tstep;
    PG8_STAGE(PG8_SB(0, 0), cB, voffB); PG8_STAGE(PG8_SB(0, 1), cB + hstep, voffB); PG8_STAGE(PG8_SA(0, 0), cA, voffA); PG8_STAGE(PG8_SA(0, 1), cA + hstep, voffA);
    if (wr == 1) PG8_BAR;
    PG8_WAIT_V(2); PG8_BAR;
    PG8_STAGE(PG8_SB(1, 0), cB + kstep, voffB); PG8_STAGE(PG8_SA(1, 0), cA + kstep, voffA); PG8_STAGE(PG8_SB(1, 1), cB + hstep + kstep, voffB);
    PG8_WAIT_V(6); PG8_BAR;
    E.finish_acc(acc, itmp);
    for (;;) {
        const bool has_next = S.next(ui + 1, nxt);
        const char* nA = has_next ? (nxt.aoff >= 0 ? (const char*)g.A0 + nxt.aoff : (const char*)(nxt.z ? g.A1 : g.A0) + (size_t)nxt.pm * tstep) : cA; const char* nB = has_next ? (const char*)(nxt.z ? g.B1 : g.B0) + (size_t)nxt.pn * tstep : cB;
        for (int t = 0; t < nt; t += 2) {
            const bool last = (t == nt - 2);
            const char* a1 = cA + (size_t)(t + 1) * kstep;
            const char* a2 = last ? nA : cA + (size_t)(t + 2) * kstep; const char* b2 = last ? nB : cB + (size_t)(t + 2) * kstep;
            const char* a3 = a2 + kstep; const char* b3 = b2 + kstep;
            PG8_LDB(B0, 0, 0); PG8_LDB(B1, 0, 1); PG8_SCHED; PG8_LDA(At, 0, 0); PG8_STAGE(PG8_SA(1, 1), a1 + hstep, voffA);
            PG8_WAIT_V(8); PG8_WAIT_L(0); PG8_BAR; PG8_MMA(0, 0, At, B0); PG8_MMA(0, 1, At, B1); PG8_BAR; PG8_SCHED;
            PG8_LDA(At, 0, 1); PG8_STAGE(PG8_SB(0, 0), b2, voffB); PG8_STAGE(PG8_SB(0, 1), b2 + hstep, voffB); PG8_STAGE(PG8_SA(0, 0), a2, voffA);
            PG8_WAIT_V(8); PG8_WAIT_L(0); PG8_BAR; PG8_MMA(1, 0, At, B0); PG8_MMA(1, 1, At, B1); PG8_BAR; PG8_SCHED;
            PG8_LDB(B0, 1, 0); PG8_LDB(B1, 1, 1); PG8_SCHED; PG8_LDA(At, 1, 0); PG8_STAGE(PG8_SA(0, 1), a2 + hstep, voffA);
            PG8_WAIT_V(8); PG8_WAIT_L(0); PG8_BAR; PG8_MMA(0, 0, At, B0); PG8_MMA(0, 1, At, B1); PG8_BAR; PG8_SCHED;
            PG8_LDA(At, 1, 1); PG8_STAGE(PG8_SB(1, 0), b3, voffB); PG8_STAGE(PG8_SB(1, 1), b3 + hstep, voffB); PG8_STAGE(PG8_SA(1, 0), a3, voffA);
            PG8_WAIT_V(8); PG8_WAIT_L(0); PG8_BAR; PG8_MMA(1, 0, At, B0); PG8_MMA(1, 1, At, B1); PG8_BAR; PG8_SCHED;
        }
        if constexpr (ALIGN_EPI) { if (wr == 0) PG8_BAR; }
        if constexpr (!Epi::AFTER_DRAIN) { E(acc, cur, wr, wc, fr, fq); S.done(ui, lane); }
        if (!has_next) break;
        if (!Epi::keep_acc(cur))
#pragma unroll
        for (int a = 0; a < 2; ++a)
#pragma unroll
            for (int b = 0; b < 2; ++b)
#pragma unroll
                for (int m = 0; m < 4; ++m)
#pragma unroll
                    for (int n = 0; n < 2; ++n) acc[a][b][m][n] = (f32x4){0.f, 0.f, 0.f, 0.f};
        cur = nxt; cA = nA; cB = nB; ++ui;
        if constexpr (ALIGN_EPI) { if (wr == 1) PG8_BAR; }
    }
    PG8_WAIT_V(0);
    if constexpr (!ALIGN_EPI) { if (wr == 0) PG8_BAR; }
    PG8_BAR;
    if constexpr (Epi::AFTER_DRAIN) { E.fused(acc, cur, wr, wc, fr, fq, lds, wid, lane); }
#undef PG8_SA
#undef PG8_SB
#undef PG8_STAGE
#undef PG8_LDA
#undef PG8_LDB
#undef PG8_MMA
#undef PG8_WAIT_V
#undef PG8_WAIT_L
#undef PG8_BAR
#undef PG8_SCHED
}

__device__ __forceinline__ u32x4 pack8(const f32x4 v0, const f32x4 v1) { u32x4 w; w.x = cvt_pk_h(v0[0], v0[1]); w.y = cvt_pk_h(v0[2], v0[3]); w.z = cvt_pk_h(v1[0], v1[1]); w.w = cvt_pk_h(v1[2], v1[3]); return w; }

struct EpiProj {
    static constexpr bool AFTER_DRAIN = false;
    struct Tmp {};
    __device__ __forceinline__ void init_acc(f32x4 (&acc)[2][2][4][2], Tmp&, const Unit&, int, int, int, int) const {
#pragma unroll
        for (int a = 0; a < 2; ++a)
#pragma unroll
            for (int b = 0; b < 2; ++b)
#pragma unroll
                for (int m = 0; m < 4; ++m)
#pragma unroll
                    for (int n = 0; n < 2; ++n) acc[a][b][m][n] = (f32x4){0.f, 0.f, 0.f, 0.f};
    }
    __device__ __forceinline__ void finish_acc(f32x4 (&)[2][2][4][2], Tmp&) const {}
    static __device__ __forceinline__ bool keep_acc(const Unit&) { return false; }
    h16_t *CB, *U, *Q, *Kb, *Vb, *GC, *GA;
    __device__ __forceinline__ void operator()(f32x4 (&acc)[2][2][4][2], const Unit& u, int wr, int wc, int fr, int fq) const {
        const int pn = u.pn, row0 = u.pm * BM + wr * 64 + fr;
        if (pn >= 4 && pn < 12) {
            const int col = 128 * (pn - 4) + 32 * wc + 8 * fq;
#pragma unroll
            for (int ai = 0; ai < 2; ++ai)
#pragma unroll
                for (int m = 0; m < 4; ++m) {
                    const f32x4 v0 = acc[ai][0][m][0] * acc[ai][1][m][0], v1 = acc[ai][0][m][1] * acc[ai][1][m][1];
                    *(u32x4*)(U + (size_t)(row0 + ai * HALF + m * 16) * D + col) = pack8(v0, v1);
                }
        } else if (pn >= 18) {
            const int col = 128 * (pn - 18) + 32 * wc + 8 * fq;
#pragma unroll
            for (int ai = 0; ai < 2; ++ai)
#pragma unroll
                for (int m = 0; m < 4; ++m) {
                    f32x4 r0, r1, a0, a1;
#pragma unroll
                    for (int e = 0; e < 4; ++e) { a0[e] = fmaxf(sigmoidf_(acc[ai][1][m][0][e]), 6.103515625e-5f); a1[e] = fmaxf(sigmoidf_(acc[ai][1][m][1][e]), 6.103515625e-5f); }
                    const u32x4 aw = pack8(a0, a1);
                    a0[0] = h_lo(aw.x); a0[1] = h_hi(aw.x); a0[2] = h_lo(aw.y); a0[3] = h_hi(aw.y); a1[0] = h_lo(aw.z); a1[1] = h_hi(aw.z); a1[2] = h_lo(aw.w); a1[3] = h_hi(aw.w);
#pragma unroll
                    for (int e = 0; e < 4; ++e) { r0[e] = sigmoidf_(acc[ai][0][m][0][e]) * __builtin_amdgcn_rcpf(a0[e]); r1[e] = sigmoidf_(acc[ai][0][m][1][e]) * __builtin_amdgcn_rcpf(a1[e]); }
                    const size_t off = (size_t)(row0 + ai * HALF + m * 16) * D + col;
                    *(u32x4*)(GC + off) = pack8(r0, r1);
                    *(u32x4*)(GA + off) = aw;
                }
        } else {
            h16_t* base; int ldc = D, colt; float sc = 1.f;
            if (pn < 4) { base = CB; colt = pn * 256; }
            else if (pn < 16) { base = Q; colt = (pn - 12) * 256; sc = 0.125f * 1.4426950408889634f; }
            else if (pn == 16) { base = Kb; colt = 0; ldc = DKV; }
            else { base = Vb; colt = 0; ldc = DKV; }
            const int col = colt + 32 * wc + 8 * fq;
#pragma unroll
            for (int ai = 0; ai < 2; ++ai)
#pragma unroll
                for (int m = 0; m < 4; ++m) { h16_t* rowp = base + (size_t)(row0 + ai * HALF + m * 16) * ldc + col;
#pragma unroll
                    for (int bj = 0; bj < 2; ++bj) { f32x4 v0 = acc[ai][bj][m][0], v1 = acc[ai][bj][m][1];
                        v0 = v0 * sc; v1 = v1 * sc;
                        *(u32x4*)(rowp + bj * HALF) = pack8(v0, v1); } }
        }
    }
};

struct EpiGated {
    static constexpr bool AFTER_DRAIN = false;
    struct Tmp {};
    __device__ __forceinline__ void init_acc(f32x4 (&acc)[2][2][4][2], Tmp&, const Unit&, int, int, int, int) const {
#pragma unroll
        for (int a = 0; a < 2; ++a)
#pragma unroll
            for (int b = 0; b < 2; ++b)
#pragma unroll
                for (int m = 0; m < 4; ++m)
#pragma unroll
                    for (int n = 0; n < 2; ++n) acc[a][b][m][n] = (f32x4){0.f, 0.f, 0.f, 0.f};
    }
    __device__ __forceinline__ void finish_acc(f32x4 (&)[2][2][4][2], Tmp&) const {}
    static __device__ __forceinline__ bool keep_acc(const Unit& u) { return u.z == 0; }
    const h16_t* R; h16_t* SA;
    __device__ __forceinline__ void operator()(f32x4 (&acc)[2][2][4][2], const Unit& u, int wr, int wc, int fr, int fq) const {
        const int row0 = u.pm * BM + wr * 64 + fr, col0 = u.pn * BM + 32 * wc + 8 * fq;
        if (u.z == 0) {
#pragma unroll
            for (int ai = 0; ai < 2; ++ai)
#pragma unroll
                for (int m = 0; m < 4; ++m)
#pragma unroll
                    for (int bj = 0; bj < 2; ++bj) {
                        const size_t off = (size_t)(row0 + ai * HALF + m * 16) * D + col0 + bj * HALF;
                        const u32x4 gw = *(const u32x4*)(R + off);
                        f32x4 v0 = acc[ai][bj][m][0], v1 = acc[ai][bj][m][1];
                        v0[0] *= h_lo(gw.x); v0[1] *= h_hi(gw.x); v0[2] *= h_lo(gw.y); v0[3] *= h_hi(gw.y);
                        v1[0] *= h_lo(gw.z); v1[1] *= h_hi(gw.z); v1[2] *= h_lo(gw.w); v1[3] *= h_hi(gw.w);
                        acc[ai][bj][m][0] = v0; acc[ai][bj][m][1] = v1;
                    }
        } else {
#pragma unroll
            for (int ai = 0; ai < 2; ++ai)
#pragma unroll
                for (int m = 0; m < 4; ++m)
#pragma unroll
                    for (int bj = 0; bj < 2; ++bj) {
                        const size_t off = (size_t)(row0 + ai * HALF + m * 16) * D + col0 + bj * HALF;
                        const u32x4 gw = *(const u32x4*)(SA + off);
                        f32x4 v0 = acc[ai][bj][m][0], v1 = acc[ai][bj][m][1];
                        v0[0] *= h_lo(gw.x); v0[1] *= h_hi(gw.x); v0[2] *= h_lo(gw.y); v0[3] *= h_hi(gw.y);
                        v1[0] *= h_lo(gw.z); v1[1] *= h_hi(gw.z); v1[2] *= h_lo(gw.w); v1[3] *= h_hi(gw.w);
                        *(u32x4*)(SA + off) = pack8(v0, v1);
                    }
        }
    }
};

struct EpiResid {
    static constexpr bool AFTER_DRAIN = true;
    struct Tmp {};
    __device__ __forceinline__ void init_acc(f32x4 (&acc)[2][2][4][2], Tmp&, const Unit& u, int wr, int wc, int fr, int fq) const {
        const int col0 = u.pn * BM + 32 * wc + 8 * fq;
#pragma unroll
        for (int ai = 0; ai < 2; ++ai)
#pragma unroll
            for (int m = 0; m < 4; ++m) { const size_t off = (size_t)(u.pm * BM + ai * HALF + wr * 64 + m * 16 + fr) * D + col0;
#pragma unroll
                for (int bj = 0; bj < 2; ++bj) { acc[ai][bj][m][0] = *(const f32x4*)(base + off + bj * HALF); acc[ai][bj][m][1] = *(const f32x4*)(base + off + bj * HALF + 4); } }
    }
    __device__ __forceinline__ void finish_acc(f32x4 (&)[2][2][4][2], Tmp&) const {}
    static __device__ __forceinline__ bool keep_acc(const Unit&) { return false; }
    const float* base; h16_t* xh; float* rowpart;
    __device__ __forceinline__ void fused(f32x4 (&acc)[2][2][4][2], const Unit& u, int wr, int wc, int fr, int fq, LAS unsigned char* lds, int wid, int lane) const {
        LAS float* P = (LAS float*)lds;
        const int col0 = u.pn * BM + 32 * wc + 8 * fq;
#pragma unroll
        for (int ai = 0; ai < 2; ++ai)
#pragma unroll
            for (int m = 0; m < 4; ++m) {
                const int rl = ai * HALF + wr * 64 + m * 16 + fr; const size_t off = (size_t)(u.pm * BM + rl) * D + col0;
                float ss = 0.f;
#pragma unroll
                for (int bj = 0; bj < 2; ++bj) {
                    const f32x4 v0 = acc[ai][bj][m][0], v1 = acc[ai][bj][m][1];
                    *(u32x4*)(xh + off + bj * HALF) = pack8(v0, v1);
                    ss += (v0[0] * v0[0] + v0[1] * v0[1]) + (v0[2] * v0[2] + v0[3] * v0[3]) + (v1[0] * v1[0] + v1[1] * v1[1]) + (v1[2] * v1[2] + v1[3] * v1[3]);
                }
                ss += __shfl_xor(ss, 16); ss += __shfl_xor(ss, 32);
                if (fq == 0) P[rl * 4 + wc] = ss;
            }
        __syncthreads();
        const int tid = wid * 64 + lane;
        if (tid < 256) { const f32x4 p = *(const LAS f32x4*)(P + tid * 4); rowpart[(size_t)(u.pm * BM + tid) * 4 + u.pn] = (p[0] + p[1]) + (p[2] + p[3]); }
    }
};

struct EpiSwiGLU {
    static constexpr bool AFTER_DRAIN = false;
    struct Tmp {};
    __device__ __forceinline__ void init_acc(f32x4 (&acc)[2][2][4][2], Tmp&, const Unit&, int, int, int, int) const {
#pragma unroll
        for (int a = 0; a < 2; ++a)
#pragma unroll
            for (int b = 0; b < 2; ++b)
#pragma unroll
                for (int m = 0; m < 4; ++m)
#pragma unroll
                    for (int n = 0; n < 2; ++n) acc[a][b][m][n] = (f32x4){0.f, 0.f, 0.f, 0.f};
    }
    __device__ __forceinline__ void finish_acc(f32x4 (&)[2][2][4][2], Tmp&) const {}
    static __device__ __forceinline__ bool keep_acc(const Unit&) { return false; }
    unsigned char* wsb; const float* rowpart;
    __device__ __forceinline__ void operator()(f32x4 (&acc)[2][2][4][2], const Unit& u, int wr, int wc, int fr, int fq) const {
        const int row0 = u.pm * BM + wr * 64 + fr, col = 128 * u.pn + 32 * wc + 8 * fq;
        h16_t* ACT = (h16_t*)(wsb + act_slot(u.pm)) - (size_t)(u.pm * BM) * DFF;
#pragma unroll
        for (int ai = 0; ai < 2; ++ai)
#pragma unroll
            for (int m = 0; m < 4; ++m) {
                const int row = row0 + ai * HALF + m * 16;
                const f32x4 p = *(const f32x4*)(rowpart + (size_t)row * 4);
                const float rs = 1.0f / sqrtf(((p[0] + p[1]) + (p[2] + p[3])) * (1.0f / D) + EPS);
                f32x4 o[2];
#pragma unroll
                for (int n = 0; n < 2; ++n)
#pragma unroll
                    for (int e = 0; e < 4; ++e) { const float gv = acc[ai][0][m][n][e] * rs, uv = acc[ai][1][m][n][e] * rs; o[n][e] = gv * sigmoidf_(gv) * uv; }
                *(u32x4*)(ACT + (size_t)row * DFF + col) = pack8(o[0], o[1]);
            }
    }
};

struct EpiFinal {
    static constexpr bool AFTER_DRAIN = true;
    struct Tmp { u32x4 w[2][4][2]; };
    __device__ __forceinline__ void init_acc(f32x4 (&)[2][2][4][2], Tmp& t, const Unit& u, int wr, int wc, int fr, int fq) const {
        const int col0 = u.pn * BM + 32 * wc + 8 * fq;
#pragma unroll
        for (int ai = 0; ai < 2; ++ai)
#pragma unroll
            for (int m = 0; m < 4; ++m) { const size_t off = (size_t)(u.pm * BM + ai * HALF + wr * 64 + m * 16 + fr) * D + col0;
#pragma unroll
                for (int bj = 0; bj < 2; ++bj) t.w[ai][m][bj] = *(const u32x4*)(xh + off + bj * HALF); }
    }
    __device__ __forceinline__ void finish_acc(f32x4 (&acc)[2][2][4][2], Tmp& t) const {
#pragma unroll
        for (int ai = 0; ai < 2; ++ai)
#pragma unroll
            for (int m = 0; m < 4; ++m)
#pragma unroll
                for (int bj = 0; bj < 2; ++bj) { const u32x4 hw = t.w[ai][m][bj];
                    acc[ai][bj][m][0] = (f32x4){h_lo(hw.x), h_hi(hw.x), h_lo(hw.y), h_hi(hw.y)}; acc[ai][bj][m][1] = (f32x4){h_lo(hw.z), h_hi(hw.z), h_lo(hw.w), h_hi(hw.w)}; }
    }
    static __device__ __forceinline__ bool keep_acc(const Unit&) { return false; }
    const h16_t* xh; float* out; const float* gfin; float* slots; unsigned* cnt;
    __device__ __forceinline__ void fused(f32x4 (&acc)[2][2][4][2], const Unit& u, int wr, int wc, int fr, int fq, LAS unsigned char* lds, int wid, int lane) const {
        LAS float* P = (LAS float*)lds;
        LAS float* S = (LAS float*)(lds + 4096);
        const int col0 = u.pn * BM + 32 * wc + 8 * fq;
#pragma unroll
        for (int ai = 0; ai < 2; ++ai)
#pragma unroll
            for (int m = 0; m < 4; ++m) {
                const int rl = ai * HALF + wr * 64 + m * 16 + fr; const size_t off = (size_t)(u.pm * BM + rl) * D + col0;
                float ss = 0.f;
#pragma unroll
                for (int bj = 0; bj < 2; ++bj) {
                    const f32x4 v0 = acc[ai][bj][m][0], v1 = acc[ai][bj][m][1];
                    ss += (v0[0] * v0[0] + v0[1] * v0[1]) + (v0[2] * v0[2] + v0[3] * v0[3]) + (v1[0] * v1[0] + v1[1] * v1[1]) + (v1[2] * v1[2] + v1[3] * v1[3]);
                }
                ss += __shfl_xor(ss, 16); ss += __shfl_xor(ss, 32);
                if (fq == 0) P[rl * 4 + wc] = ss;
            }
        __syncthreads();
        const int tid = wid * 64 + lane;
        if (tid < 256) { const f32x4 p = *(const LAS f32x4*)(P + tid * 4);
            __hip_atomic_store(slots + (size_t)(u.pm * BM + tid) * 4 + u.pn, (p[0] + p[1]) + (p[2] + p[3]), __ATOMIC_RELAXED, __HIP_MEMORY_SCOPE_AGENT); }
        asm volatile("s_waitcnt vmcnt(0)" ::: "memory");
        if (tid < 256 && lane == 0) __hip_atomic_fetch_add(cnt + 64 * u.pm, 1u, __ATOMIC_RELAXED, __HIP_MEMORY_SCOPE_AGENT);
        if (wid == 0) {
            unsigned sp = 0;
            while ((unsigned)__builtin_amdgcn_readfirstlane(__hip_atomic_load(cnt + 64 * u.pm, __ATOMIC_RELAXED, __HIP_MEMORY_SCOPE_AGENT)) < 16u) { __builtin_amdgcn_s_sleep(1); if (++sp > (1u << 22)) break; }
            __builtin_amdgcn_fence(__ATOMIC_ACQUIRE, "agent");
        }
        asm volatile("s_waitcnt vmcnt(0) lgkmcnt(0)" ::: "memory");
        __syncthreads();
        if (tid < 256) { const float* sl = slots + (size_t)(u.pm * BM + tid) * 4; float t = 0.f;
#pragma unroll
            for (int q = 0; q < 4; ++q) t += __hip_atomic_load(sl + q, __ATOMIC_RELAXED, __HIP_MEMORY_SCOPE_AGENT);
            S[tid] = 1.0f / sqrtf(t * (1.0f / D) + EPS); }
        __syncthreads();
        f32x4 gv[2][2];
#pragma unroll
        for (int bj = 0; bj < 2; ++bj) { gv[bj][0] = *(const f32x4*)(gfin + col0 + bj * HALF); gv[bj][1] = *(const f32x4*)(gfin + col0 + bj * HALF + 4); }
#pragma unroll
        for (int ai = 0; ai < 2; ++ai)
#pragma unroll
            for (int m = 0; m < 4; ++m) {
                const int rl = ai * HALF + wr * 64 + m * 16 + fr; const size_t off = (size_t)(u.pm * BM + rl) * D + col0; const float rs = S[rl];
#pragma unroll
                for (int bj = 0; bj < 2; ++bj) { *(f32x4*)(out + off + bj * HALF) = acc[ai][bj][m][0] * rs * gv[bj][0]; *(f32x4*)(out + off + bj * HALF + 4) = acc[ai][bj][m][1] * rs * gv[bj][1]; }
            }
    }
};
}

__device__ __forceinline__ void p0_transpose_item(const float* W, int K, int N, h16_t* WT, int dst_row0, int n0, int k0, const float* kscale, LAS unsigned* scr, int lane) {
    const int nq = lane & 7, kq = lane >> 3;
    f32x4 ra[4], rb[4];
#pragma unroll
    for (int t = 0; t < 4; ++t) { const int kp = kq + 8 * t; const float* p = W + (size_t)(k0 + 2 * kp) * N + n0 + 4 * nq; ra[t] = __builtin_nontemporal_load((const f32x4*)p); rb[t] = __builtin_nontemporal_load((const f32x4*)(p + N)); }
#pragma unroll
    for (int t = 0; t < 4; ++t) { const int kp = kq + 8 * t; float s0 = 1.f, s1 = 1.f; if (kscale) { s0 = kscale[k0 + 2 * kp]; s1 = kscale[k0 + 2 * kp + 1]; }
#pragma unroll
        for (int i = 0; i < 4; ++i) scr[(4 * nq + i) * 33 + kp] = cvt_pk_h(ra[t][i] * s0, rb[t][i] * s1); }
    LDS_WAIT(); asm volatile("" ::: "memory");
    const int c = lane & 7;
#pragma unroll
    for (int j = 0; j < 4; ++j) { const int n = (lane >> 3) + 8 * j; const LAS unsigned* sp = scr + n * 33 + 4 * c;
        u32x4 o; o.x = sp[0]; o.y = sp[1]; o.z = sp[2]; o.w = sp[3];
        *(u32x4*)(WT + (size_t)(dst_row0 + n) * K + k0 + 8 * c) = o; }
    LDS_WAIT(); asm volatile("" ::: "memory");
}
__device__ __forceinline__ int map_win(int n) {
    if (n < 1024 || (n >= 3072 && n < 4608)) return n;
    if (n >= 4608) { const int c = (n - 4608) & 1023, isa = (n >= 5632) ? 1 : 0; return 4608 + 256 * (c >> 7) + 128 * isa + (c & 127); }
    const int c = (n - 1024) & 1023, isx = (n >= 2048) ? 1 : 0;
    return 1024 + 256 * (c >> 7) + 128 * isx + (c & 127);
}
__device__ __forceinline__ int map_wgu(int n) {
    const int isu = (n >= DFF) ? 1 : 0, c = n - isu * DFF;
    return 256 * (c >> 7) + 128 * isu + (c & 127);
}

constexpr int KS_STRIDE = 72, VT_STRIDE = 264;
constexpr int LDS_KS = 0, LDS_VT = 256 * KS_STRIDE * 2;

constexpr int ATT_UNIT_LDS = 70656;
struct QRaw { u32x4 a0, a1; h16x8 q1, q2, q3; f32x4 c0, c1, s0, s1; };
__device__ __forceinline__ void attn_qload(QRaw& r, const h16_t* qp, const float* ropep, int hi) {
    r.a0 = *(const u32x4*)qp; r.a1 = *(const u32x4*)(qp + 8);
    r.q1 = *(const h16x8*)(qp + 16 + 8 * hi); r.q2 = *(const h16x8*)(qp + 32 + 8 * hi); r.q3 = *(const h16x8*)(qp + 48 + 8 * hi);
    const f32x4* cs = (const f32x4*)ropep; r.c0 = cs[0]; r.c1 = cs[1]; r.s0 = cs[2]; r.s1 = cs[3];
}
__device__ __forceinline__ void attn_pair(LAS unsigned char* lds, int un0, h16_t* QO, const h16_t* Kb, const h16_t* Vb, const float* rope, const float* sinks) {
    const int tid = threadIdx.x, lane = tid & 63, wid = __builtin_amdgcn_readfirstlane(tid >> 6);
    const int qi = lane & 31, hi = lane >> 5;
    QRaw qc;
    {
        const int blk = un0 & 15, kvh = (un0 >> 4) & 3, b = un0 >> 6, head = kvh * 4 + (wid >> 1);
        const int qpos = blk * 128 + ((wid & 1) * 2) * 32 + qi;
        attn_qload(qc, QO + ((size_t)b * SEQ + qpos) * D + head * HD, rope + (size_t)qpos * 16, hi);
    }
    {
        const int kk = tid >> 1, half = tid & 1;
        u32x4 kv[2][4], vv[2][4]; f32x4 cs[2][4];
#pragma unroll
        for (int uu = 0; uu < 2; ++uu) {
            const int un = un0 + uu, blk = un & 15, kvh = (un >> 4) & 3, b = un >> 6;
            const int pos = blk * 128 - 128 + kk;
#pragma unroll
            for (int i = 0; i < 4; ++i) { kv[uu][i] = (u32x4){0u, 0u, 0u, 0u}; vv[uu][i] = (u32x4){0u, 0u, 0u, 0u}; cs[uu][i] = (f32x4){0.f, 0.f, 0.f, 0.f}; }
            if (pos >= 0) {
                const size_t row = (size_t)b * SEQ + pos;
                const u32x4* kp = (const u32x4*)(Kb + row * DKV + kvh * HD + half * 32);
                const u32x4* vp = (const u32x4*)(Vb + row * DKV + kvh * HD + half * 32);
#pragma unroll
                for (int i = 0; i < 4; ++i) { kv[uu][i] = kp[i]; vv[uu][i] = vp[i]; }
                if (half == 0) { const f32x4* cp = (const f32x4*)(rope + (size_t)pos * 16);
#pragma unroll
                    for (int i = 0; i < 4; ++i) cs[uu][i] = cp[i]; }
            }
        }
#pragma unroll
        for (int uu = 0; uu < 2; ++uu) {
            LAS h16_t* Ks = (LAS h16_t*)(lds + uu * ATT_UNIT_LDS + LDS_KS);
            LAS h16_t* VT = (LAS h16_t*)(lds + uu * ATT_UNIT_LDS + LDS_VT);
            if (half == 0) {
                float r1[8], r2[8], o1[8], o2[8];
#pragma unroll
                for (int e = 0; e < 4; ++e) { r1[2 * e] = h_lo(kv[uu][0][e]); r1[2 * e + 1] = h_hi(kv[uu][0][e]); r2[2 * e] = h_lo(kv[uu][1][e]); r2[2 * e + 1] = h_hi(kv[uu][1][e]); }
#pragma unroll
                for (int e = 0; e < 8; ++e) { const float c = e < 4 ? cs[uu][0][e & 3] : cs[uu][1][e & 3], sn = e < 4 ? cs[uu][2][e & 3] : cs[uu][3][e & 3]; o1[e] = r1[e] * c - r2[e] * sn; o2[e] = r2[e] * c + r1[e] * sn; }
#pragma unroll
                for (int e = 0; e < 4; ++e) { kv[uu][0][e] = cvt_pk_h(o1[2 * e], o1[2 * e + 1]); kv[uu][1][e] = cvt_pk_h(o2[2 * e], o2[2 * e + 1]); }
            }
#pragma unroll
            for (int i = 0; i < 4; ++i) *(LAS u32x4*)(Ks + kk * KS_STRIDE + half * 32 + 8 * i) = kv[uu][i];
#pragma unroll
            for (int i = 0; i < 4; ++i)
#pragma unroll
                for (int e = 0; e < 4; ++e) {
                    const int d = half * 32 + 8 * i + 2 * e;
                    VT[d * VT_STRIDE + kk] = (h16_t)(vv[uu][i][e] & 0xffffu);
                    VT[(d + 1) * VT_STRIDE + kk] = (h16_t)(vv[uu][i][e] >> 16);
                }
        }
    }
    __syncthreads();
    const int pk = (qi & 3) | (((qi >> 3) & 1) << 2) | (((qi >> 2) & 1) << 3) | (qi & 16);
#pragma unroll 1
    for (int st = 0; st < 4; ++st) {
        const int un = un0 + (st >> 1), blk = un & 15, kvh = (un >> 4) & 3, b = un >> 6, head = kvh * 4 + (wid >> 1);
        const int q0 = ((wid & 1) * 2 + (st & 1)) * 32;
        const int qpos = blk * 128 + q0 + qi;
        h16_t* qp = QO + ((size_t)b * SEQ + qpos) * D + head * HD;
        const float sink = sinks[head];
        LAS h16_t* Ks = (LAS h16_t*)(lds + (st >> 1) * ATT_UNIT_LDS + LDS_KS);
        LAS h16_t* VT = (LAS h16_t*)(lds + (st >> 1) * ATT_UNIT_LDS + LDS_VT);
        QRaw qn;
        {
            const int sn = st < 3 ? st + 1 : st;
            const int un_n = un0 + (sn >> 1), blk_n = un_n & 15, kvh_n = (un_n >> 4) & 3, b_n = un_n >> 6, head_n = kvh_n * 4 + (wid >> 1);
            const int qpos_n = blk_n * 128 + ((wid & 1) * 2 + (sn & 1)) * 32 + qi;
            attn_qload(qn, QO + ((size_t)b_n * SEQ + qpos_n) * D + head_n * HD, rope + (size_t)qpos_n * 16, hi);
        }
        h16x8 qf[4];
        {
            float r1[8], r2[8], o[8];
#pragma unroll
            for (int e = 0; e < 4; ++e) { r1[2 * e] = h_lo(qc.a0[e]); r1[2 * e + 1] = h_hi(qc.a0[e]); r2[2 * e] = h_lo(qc.a1[e]); r2[2 * e + 1] = h_hi(qc.a1[e]); }
#pragma unroll
            for (int e = 0; e < 8; ++e) { const float c = e < 4 ? qc.c0[e & 3] : qc.c1[e & 3], sn = e < 4 ? qc.s0[e & 3] : qc.s1[e & 3];
                o[e] = hi ? (r2[e] * c + r1[e] * sn) : (r1[e] * c - r2[e] * sn); }
            u32x4 w;
#pragma unroll
            for (int e = 0; e < 4; ++e) w[e] = cvt_pk_h(o[2 * e], o[2 * e + 1]);
            qf[0] = __builtin_bit_cast(h16x8, w); qf[1] = qc.q1; qf[2] = qc.q2; qf[3] = qc.q3;
        }
        f32x16 s[5];
#pragma unroll
        for (int j = 0; j < 5; ++j) {
            s[j] = (f32x16){0.f, 0.f, 0.f, 0.f, 0.f, 0.f, 0.f, 0.f, 0.f, 0.f, 0.f, 0.f, 0.f, 0.f, 0.f, 0.f};
#pragma unroll
            for (int ks = 0; ks < 4; ++ks) {
                const h16x8 kf = *(const LAS h16x8*)(Ks + (q0 + 32 * j + pk) * KS_STRIDE + 16 * ks + 8 * hi);
                s[j] = __builtin_amdgcn_mfma_f32_32x32x16_f16(kf, qf[ks], s[j], 0, 0, 0);
            }
        }
        const float NEG = -1e30f;
        const float sinkl = sink * 1.4426950408889634f;
        if (blk == 0) {
#pragma unroll
            for (int j = 0; j < 4; ++j) if (j < 4 - (q0 >> 5)) {
#pragma unroll
                for (int r = 0; r < 16; ++r) s[j][r] = NEG; }
        }
#pragma unroll
        for (int r = 0; r < 16; ++r) { const int kl = (r & 7) + 8 * hi + 16 * (r >> 3); s[0][r] = (kl > qi) ? s[0][r] : NEG; s[4][r] = (kl <= qi) ? s[4][r] : NEG; }
        float mx = sinkl;
#pragma unroll
        for (int j = 0; j < 5; ++j)
#pragma unroll
            for (int r = 0; r < 16; ++r) mx = fmaxf(mx, s[j][r]);
        mx = fmaxf(mx, __shfl_xor(mx, 32));
        float sum = 0.f;
#pragma unroll
        for (int j = 0; j < 5; ++j)
#pragma unroll
            for (int r = 0; r < 16; ++r) { const float p = __builtin_amdgcn_exp2f(s[j][r] - mx); s[j][r] = p; sum += p; }
        sum += __shfl_xor(sum, 32);
        sum += __builtin_amdgcn_exp2f(sinkl - mx);
        const float inv = 1.0f / sum;
        f32x16 o[2];
        o[0] = (f32x16){0.f, 0.f, 0.f, 0.f, 0.f, 0.f, 0.f, 0.f, 0.f, 0.f, 0.f, 0.f, 0.f, 0.f, 0.f, 0.f}; o[1] = o[0];
#pragma unroll
        for (int j = 0; j < 5; ++j)
#pragma unroll
            for (int h = 0; h < 2; ++h) {
                u32x4 w;
#pragma unroll
                for (int e = 0; e < 4; ++e) w[e] = cvt_pk_h(s[j][8 * h + 2 * e], s[j][8 * h + 2 * e + 1]);
                const h16x8 pf = __builtin_bit_cast(h16x8, w);
#pragma unroll
                for (int dt = 0; dt < 2; ++dt) {
                    const h16x8 vf = *(const LAS h16x8*)(VT + (dt * 32 + qi) * VT_STRIDE + q0 + 32 * j + 16 * h + 8 * hi);
                    o[dt] = __builtin_amdgcn_mfma_f32_32x32x16_f16(vf, pf, o[dt], 0, 0, 0);
                }
            }
#pragma unroll
        for (int dt = 0; dt < 2; ++dt)
#pragma unroll
            for (int r = 0; r < 16; ++r) o[dt][r] *= inv;
#pragma unroll
        for (int dt = 0; dt < 2; ++dt)
#pragma unroll
            for (int g4 = 0; g4 < 4; ++g4) {
                u32x2 w; w.x = cvt_pk_h(o[dt][4 * g4], o[dt][4 * g4 + 1]); w.y = cvt_pk_h(o[dt][4 * g4 + 2], o[dt][4 * g4 + 3]);
                *(u32x2*)(qp + 32 * dt + 8 * g4 + 4 * hi) = w;
            }
        qc = qn;
    }
    __syncthreads();
}

__device__ __forceinline__ void conv_item(int it, const h16_t* U, h16_t* CB, const float* cw) {
    const int tid = threadIdx.x, tc = tid >> 7, cgp = tid & 127;
    const int t0 = 64 * it + 16 * tc, c0 = 8 * cgp;
    u32x4 uw[18], bw[16];
    const bool first = (t0 & (SEQ - 1)) == 0;
    uw[0] = (u32x4){0u, 0u, 0u, 0u}; uw[1] = uw[0];
    if (!first) { uw[0] = *(const u32x4*)(U + (size_t)(t0 - 2) * D + c0); uw[1] = *(const u32x4*)(U + (size_t)(t0 - 1) * D + c0); }
#pragma unroll
    for (int i = 0; i < 16; ++i) { const size_t off = (size_t)(t0 + i) * D + c0; uw[i + 2] = *(const u32x4*)(U + off); bw[i] = *(const u32x4*)(CB + off); }
    float w0[8], w1[8], w2[8];
#pragma unroll
    for (int h = 0; h < 2; ++h) { const f32x4 a = *(const f32x4*)(cw + c0 + 4 * h), bq = *(const f32x4*)(cw + D + c0 + 4 * h), c = *(const f32x4*)(cw + 2 * D + c0 + 4 * h);
#pragma unroll
        for (int e = 0; e < 4; ++e) { w0[4 * h + e] = a[e]; w1[4 * h + e] = bq[e]; w2[4 * h + e] = c[e]; } }
#pragma unroll
    for (int i = 0; i < 16; ++i) {
        u32x4 o;
#pragma unroll
        for (int e = 0; e < 4; ++e) {
            const float ylo = h_lo(bw[i][e]) * (w0[2 * e] * h_lo(uw[i][e]) + w1[2 * e] * h_lo(uw[i + 1][e]) + w2[2 * e] * h_lo(uw[i + 2][e]));
            const float yhi = h_hi(bw[i][e]) * (w0[2 * e + 1] * h_hi(uw[i][e]) + w1[2 * e + 1] * h_hi(uw[i + 1][e]) + w2[2 * e + 1] * h_hi(uw[i + 2][e]));
            o[e] = cvt_pk_h(ylo, yhi);
        }
        *(u32x4*)(CB + (size_t)(t0 + i) * D + c0) = o;
    }
}

#define XB_TMO      128
#define XB_XCNT(j)  (256  + 64 * (j))
#define XB_XSUB(j)  (1280 + 64 * (j))
#define XB_XGEN(j)  (2304 + 64 * (j))
#define XB_TOP      3328
#define XB_TOPGEN   3392
#define XCD_BAR_WORDS 3456
#define XB_SPIN_CAP (1u << 18)
__device__ __forceinline__ unsigned xb_ld(unsigned* p)              { return __hip_atomic_load(p, __ATOMIC_RELAXED, __HIP_MEMORY_SCOPE_AGENT); }
__device__ __forceinline__ unsigned xb_add(unsigned* p, unsigned v) { return __hip_atomic_fetch_add(p, v, __ATOMIC_RELAXED, __HIP_MEMORY_SCOPE_AGENT); }
#define XB_SPIN(cond, bar) do { unsigned _sp = 0; while (cond) { __builtin_amdgcn_s_sleep(1); \
    if ((++_sp & 255u) == 0u) { if (xb_ld(&(bar)[XB_TMO])) break; if (_sp > XB_SPIN_CAP) { atomicAdd(&(bar)[XB_TMO], 1u); break; } } } } while (0)
struct XcdBarrier { unsigned* bar; unsigned x; volatile LAS unsigned* st; };
__device__ __forceinline__ XcdBarrier xcd_barrier_post(unsigned* bar, volatile LAS unsigned* st) {
    XcdBarrier b; b.bar = bar; b.x = xb_xcc_id(); b.st = st;
    if (threadIdx.x == 0) (void)xb_add(&bar[XB_XCNT(b.x)], 1u);
    return b;
}
__device__ __forceinline__ void xcd_barrier_complete(unsigned* bar, unsigned x, unsigned& nloc, unsigned& nx) {
    const unsigned G = gridDim.x * gridDim.y * gridDim.z;
    unsigned sum, cnt, mine, sp = 0u;
    for (;;) {
        sum = 0u; cnt = 0u; mine = 0u;
#pragma unroll
        for (unsigned j = 0; j < 16; ++j) { const unsigned c = xb_ld(&bar[XB_XCNT(j)]); sum += c; cnt += (c > 0u) ? 1u : 0u; mine = (j == x) ? c : mine; }
        if (sum == G) break;
        __builtin_amdgcn_s_sleep(1);
        if ((++sp & 255u) == 0u) { if (xb_ld(&bar[XB_TMO])) break; if (sp > XB_SPIN_CAP) { atomicAdd(&bar[XB_TMO], 1u); break; } }
    }
    nloc = mine > 0u ? mine : 1u; nx = cnt > 0u ? cnt : 1u;
}
__device__ __forceinline__ void xcd_barrier(const XcdBarrier& b) {
    asm volatile("s_waitcnt vmcnt(0)" ::: "memory");
    __syncthreads();
    if (threadIdx.x == 0) {
        unsigned* bar = b.bar;
        __builtin_amdgcn_s_waitcnt(0);
        unsigned nloc = b.st[0], nx = b.st[1];
        if (nloc == 0u) { xcd_barrier_complete(bar, b.x, nloc, nx); b.st[0] = nloc; b.st[1] = nx; }
        const unsigned old = xb_add(&bar[XB_XSUB(b.x)], 1u);
        const unsigned gen = old / nloc;
        if (old + 1u == (gen + 1u) * nloc) {
            __builtin_amdgcn_fence(__ATOMIC_RELEASE, "agent");
            asm volatile("s_waitcnt vmcnt(0)" ::: "memory");
            const unsigned og = xb_add(&bar[XB_TOP], 1u);
            const unsigned tg = og / nx;
            if (og + 1u == (tg + 1u) * nx) xb_add(&bar[XB_TOPGEN], 1u);
            else XB_SPIN(xb_ld(&bar[XB_TOPGEN]) == tg, bar);
            __builtin_amdgcn_fence(__ATOMIC_ACQUIRE, "agent");
            xb_add(&bar[XB_XGEN(b.x)], 1u);
            asm volatile("s_waitcnt vmcnt(0)" ::: "memory");
        } else {
            XB_SPIN(xb_ld(&bar[XB_XGEN(b.x)]) == gen, bar);
            __builtin_amdgcn_fence(__ATOMIC_ACQUIRE, "agent");
            asm volatile("s_waitcnt vmcnt(0)" ::: "memory");
        }
    }
    __syncthreads();
}

struct Args { const float* in[12]; float* out; unsigned char* ws; float inv_freq[8]; };

template <int PH> __device__ __forceinline__ void run_phase(const Args& a, LAS unsigned char* lds) {
    const int tid = threadIdx.x, lane = tid & 63, wave = __builtin_amdgcn_readfirstlane(tid >> 6);
    const int G = gridDim.x, bx = blockIdx.x;
    const int vcu = (G % 8 == 0) ? (bx % 8) * (G / 8) + bx / 8 : bx;
    unsigned char* ws = a.ws;
    const float* x = a.in[0]; const float* g_mix = a.in[1]; const float* w_in = a.in[2]; const float* conv_w = a.in[3]; const float* sinks = a.in[4];
    const float* w_conv_out = a.in[5]; const float* w_attn_out = a.in[6]; const float* w_o = a.in[7]; const float* g_ffn = a.in[8];
    const float* w_gate_up = a.in[9]; const float* w_down = a.in[10]; const float* g_final = a.in[11];
    float* rope = (float*)(ws + WS_ROPE); float* rp1 = (float*)(ws + WS_RP1); float* rp2 = (float*)(ws + WS_RP2);
    h16_t* Win_t = (h16_t*)(ws + WS_WIN); h16_t* Wc_t = (h16_t*)(ws + WS_WC); h16_t* Wa_t = (h16_t*)(ws + WS_WA); h16_t* Wo_t = (h16_t*)(ws + WS_WO);
    h16_t* Wgu_t = (h16_t*)(ws + WS_WGU); h16_t* Wd_t = (h16_t*)(ws + WS_WD);
    h16_t* H0 = (h16_t*)(ws + WS_H0); h16_t* Ub = (h16_t*)(ws + WS_U); h16_t* CBb = (h16_t*)(ws + WS_CB); h16_t* Qb = (h16_t*)(ws + WS_Q);
    h16_t* Kb = (h16_t*)(ws + WS_K); h16_t* Vb = (h16_t*)(ws + WS_V); h16_t* GCb = (h16_t*)(ws + WS_GC); h16_t* GAb = (h16_t*)(ws + WS_GA);
    h16_t* ACTb = (h16_t*)(ws + WS_ACT); h16_t* X1B = Qb;
    float* out = a.out;

    if constexpr (PH == 0) {
        LAS unsigned* scr = (LAS unsigned*)(lds + wave * 16384);
        const int gw = vcu * NWAVES + wave, NGW = G * NWAVES;
        constexpr int I_IN = (D / 64) * (NIN / 32);
        constexpr int I_SQ0 = (D / 64) * (D / 32);
        constexpr int I_GU0 = (D / 64) * (2 * DFF / 32), I_DN0 = (DFF / 64) * (D / 32);
        for (int it = gw; it < I_IN + 3 * I_SQ0 + I_GU0 + I_DN0; it += NGW) {
            int r = it;
            if (r < I_IN) { const int nb = r % (NIN / 32), kb = r / (NIN / 32); p0_transpose_item(w_in, D, NIN, Win_t, map_win(32 * nb), 32 * nb, 64 * kb, nullptr, scr, lane); continue; } r -= I_IN;
            if (r < 3 * I_SQ0) { const float* Wsrc = r < I_SQ0 ? w_conv_out : (r < 2 * I_SQ0 ? w_attn_out : w_o); h16_t* Wdst = r < I_SQ0 ? Wc_t : (r < 2 * I_SQ0 ? Wa_t : Wo_t); r %= I_SQ0;
                const int nb = r % (D / 32), kb = r / (D / 32); p0_transpose_item(Wsrc, D, D, Wdst, 32 * nb, 32 * nb, 64 * kb, nullptr, scr, lane); continue; } r -= 3 * I_SQ0;
            if (r < I_GU0) { const int nb = r % (2 * DFF / 32), kb = r / (2 * DFF / 32); p0_transpose_item(w_gate_up, D, 2 * DFF, Wgu_t, map_wgu(32 * nb), 32 * nb, 64 * kb, g_ffn, scr, lane); continue; } r -= I_GU0;
            { const int nb = r % (D / 32), kb = r / (D / 32); p0_transpose_item(w_down, DFF, D, Wd_t, 32 * nb, 32 * nb, 64 * kb, nullptr, scr, lane); }
        }
        {
            f32x4 gq[4];
#pragma unroll
            for (int j = 0; j < 4; ++j) gq[j] = ((const f32x4*)g_mix)[lane + 64 * j];
            for (int m = gw; m < M; m += 4 * NGW) {
                f32x4 xv[4][4];
#pragma unroll
                for (int r = 0; r < 4; ++r) { const f32x4* xr = (const f32x4*)(x + (size_t)(m + r * NGW) * D) + lane;
#pragma unroll
                    for (int j = 0; j < 4; ++j) xv[r][j] = __builtin_nontemporal_load(xr + 64 * j); }
#pragma unroll
                for (int r = 0; r < 4; ++r) {
                    float ss = 0.f;
#pragma unroll
                    for (int j = 0; j < 4; ++j) ss += (xv[r][j][0] * xv[r][j][0] + xv[r][j][1] * xv[r][j][1]) + (xv[r][j][2] * xv[r][j][2] + xv[r][j][3] * xv[r][j][3]);
                    const float rs = 1.0f / sqrtf(wave_sum(ss) * (1.0f / D) + EPS);
                    u32x2* o8 = (u32x2*)(H0 + (size_t)(m + r * NGW) * D) + lane;
#pragma unroll
                    for (int j = 0; j < 4; ++j) { u32x2 w; w.x = cvt_pk_h(xv[r][j][0] * rs * gq[j][0], xv[r][j][1] * rs * gq[j][1]); w.y = cvt_pk_h(xv[r][j][2] * rs * gq[j][2], xv[r][j][3] * rs * gq[j][3]); o8[64 * j] = w; }
                }
            }
        }
        if (tid == 0) __hip_atomic_fetch_or((unsigned*)(ws + WS_GRP) + 64 * (bx & 7) + 32, 1u << xb_xcc_id(), __ATOMIC_RELAXED, __HIP_MEMORY_SCOPE_AGENT);
        for (int i = bx * NTHREADS + tid; i < SEQ * 8; i += G * NTHREADS) {
            const int pos = i >> 3, f = i & 7;
            const float ang = (float)pos * a.inv_freq[f];
            double rev = (double)ang * 0.15915494309189535; rev -= floor(rev);
            const float fr = (float)rev;
            rope[pos * 16 + f] = __builtin_amdgcn_cosf(fr); rope[pos * 16 + 8 + f] = __builtin_amdgcn_sinf(fr);
        }
    }

    const bool heavy = bx < 128; const int pj = (bx >> 3) & 15, my_pm = __builtin_amdgcn_readfirstlane(8 * (bx & 7) + (heavy ? 4 : 0) + (pj >> 2)), my_pn = __builtin_amdgcn_readfirstlane(pj & 3);
    unsigned* const r6 = (unsigned*)(ws + WS_R6); unsigned* const r7 = (unsigned*)(ws + WS_R7); unsigned* const pbar = (unsigned*)(ws + WS_PB) + 64 * my_pm;
    if constexpr (PH == 1) {
        unsigned* const grp = (unsigned*)(ws + WS_GRP) + 64 * (bx & 7);
        const unsigned gm = __hip_atomic_load(grp + 32, __ATOMIC_RELAXED, __HIP_MEMORY_SCOPE_AGENT); const bool samex = (gm & (gm - 1u)) == 0u;
        pg8::Gemm g{H0, Win_t, H0, Win_t, D};
        pg8::ProjOrder S{bx, grp, grp + 16, samex};
        pg8::EpiProj E{CBb, Ub, Qb, Kb, Vb, GCb, GAb};
        pg8::gemm_phase<pg8::EpiProj, pg8::ProjOrder, true>(lds, g, S, E);
        if (heavy) block_wait2(grp, 32u * NWAVES, grp + 16, 16u * NWAVES);
        else block_wait(grp, 32u * NWAVES);
    }

    if constexpr (PH == 2) {
        conv_item(4 * my_pm + my_pn, Ub, CBb, conv_w);
        attn_pair(lds, (((my_pm >> 3) * 4 + my_pn) << 4) + 2 * (my_pm & 7), Qb, Kb, Vb, rope, sinks);
        { const unsigned gm_ = (unsigned)__builtin_amdgcn_readfirstlane((int)__hip_atomic_load((unsigned*)(ws + WS_GRP) + 64 * (bx & 7) + 32, __ATOMIC_RELAXED, __HIP_MEMORY_SCOPE_AGENT)); group_barrier(pbar, 4u, (gm_ & (gm_ - 1u)) == 0u); }
    }

    if constexpr (PH == 3) {
        pg8::Gemm g{CBb, Wc_t, Qb, Wa_t, D}; pg8::DualOrder S; S.so.init(M, D, G, (my_pm >> 3) + 8 * (my_pm & 7) + 64 * my_pn);
        pg8::EpiGated E{GCb, GAb};
        pg8::gemm_phase<pg8::EpiGated, pg8::DualOrder, true>(lds, g, S, E);
        { const unsigned gm_ = (unsigned)__builtin_amdgcn_readfirstlane((int)__hip_atomic_load((unsigned*)(ws + WS_GRP) + 64 * (bx & 7) + 32, __ATOMIC_RELAXED, __HIP_MEMORY_SCOPE_AGENT)); group_barrier(pbar, 8u, (gm_ & (gm_ - 1u)) == 0u); }
    }

    if constexpr (PH == 4) {
        pg8::Gemm g{GAb, Wo_t, GAb, Wo_t, D}; pg8::StaticOrder S; S.init(M, D, G, (my_pm >> 3) + 8 * (my_pm & 7) + 64 * my_pn);
        pg8::EpiResid E{x, X1B, rp1};
        pg8::gemm_phase<pg8::EpiResid, pg8::StaticOrder, false>(lds, g, S, E);
    }

    if constexpr (PH == 5) {
        unsigned* const grp = (unsigned*)(ws + WS_GRP) + 64 * (bx & 7);
        {
            const unsigned gm_ = (unsigned)__builtin_amdgcn_readfirstlane((int)__hip_atomic_load(grp + 32, __ATOMIC_RELAXED, __HIP_MEMORY_SCOPE_AGENT)); const bool sx = (gm_ & (gm_ - 1u)) == 0u;
            if (!heavy) group_barrier2(grp + 40, 16u, grp + 16, 16u * NWAVES, sx); else group_barrier(grp + 48, 16u, sx);
        }
        pg8::Gemm g{X1B, Wgu_t, X1B, Wgu_t, D}; pg8::SwiOrder S{bx, grp + 48, 16u};
        pg8::EpiSwiGLU E{ws, rp1};
        pg8::gemm_phase<pg8::EpiSwiGLU, pg8::SwiOrder, true>(lds, g, S, E);
    }

    if constexpr (PH == 6) {
        pg8::Gemm g{(const h16_t*)ws, Wd_t, (const h16_t*)ws, Wd_t, DFF}; pg8::StaticOrder S; S.init(M, D, G, bx, 1);
        pg8::EpiFinal E{X1B, out, g_final, rp2, (unsigned*)(ws + WS_PCNT)};
        pg8::gemm_phase<pg8::EpiFinal, pg8::StaticOrder, false>(lds, g, S, E);
    }

    if constexpr (PH == 7) {
        const int gw = vcu * NWAVES + wave, NGW = G * NWAVES;
        for (int m = gw; m < M; m += NGW) {
            const f32x4 p = *(const f32x4*)(rp2 + (size_t)m * 4);
            const float rs = 1.0f / sqrtf(((p[0] + p[1]) + (p[2] + p[3])) * (1.0f / D) + EPS);
            f32x4* xr = (f32x4*)(out + (size_t)m * D) + lane;
#pragma unroll
            for (int j = 0; j < 4; ++j) { const f32x4 gq = ((const f32x4*)g_final)[lane + 64 * j]; f32x4 v = xr[64 * j]; v = v * rs * gq; xr[64 * j] = v; }
        }
    }
}

__global__ void __launch_bounds__(NTHREADS, 2) fwd_megakernel(Args a) {
    extern __shared__ __attribute__((aligned(16))) unsigned char lds_raw[];
    LAS unsigned char* lds = (LAS unsigned char*)lds_raw;
    if (a.ws == nullptr) { cg::grid_group grid = cg::this_grid(); grid.sync(); }
    volatile LAS unsigned* st = (volatile LAS unsigned*)(lds + LDS_BAR_ST);
    if (threadIdx.x < 2) st[threadIdx.x] = 0u;
    __syncthreads();
    const XcdBarrier bar = xcd_barrier_post((unsigned*)(a.ws + WS_BAR), st);
    run_phase<0>(a, lds); xcd_barrier(bar);
    run_phase<1>(a, lds);
    run_phase<2>(a, lds);
    run_phase<3>(a, lds);
    run_phase<4>(a, lds);
    run_phase<5>(a, lds);
    { const unsigned gm_ = __hip_atomic_load((unsigned*)(a.ws + WS_GRP) + 64 * (blockIdx.x & 7) + 32, __ATOMIC_RELAXED, __HIP_MEMORY_SCOPE_AGENT);
      group_barrier((unsigned*)(a.ws + WS_GRP + 2048) + 64 * (blockIdx.x & 7), 32u, (gm_ & (gm_ - 1u)) == 0u); }
    run_phase<6>(a, lds);
}

extern "C" void kernel_launch(void* const* d_in, const int* in_sizes, int n_in, void* d_out, int out_size, void* d_ws, size_t ws_size, hipStream_t stream) {
    static int grid = 0;
    if (grid == 0) {
        if (n_in != 12 || in_sizes[0] != M * D || out_size != M * D || ws_size < WS_END) { fprintf(stderr, "kernel_launch: unexpected shapes (n_in %d, in0 %d, out %d, ws %zu)\n", n_in, n_in > 0 ? in_sizes[0] : -1, out_size, ws_size); grid = -1; return; }
        int dev = 0, cus = 0, per_cu = 0;
        if (hipGetDevice(&dev) != hipSuccess || hipDeviceGetAttribute(&cus, hipDeviceAttributeMultiprocessorCount, dev) != hipSuccess) { grid = -1; return; }
        if (hipFuncSetAttribute((const void*)fwd_megakernel, hipFuncAttributeMaxDynamicSharedMemorySize, LDS_BYTES) != hipSuccess) { fprintf(stderr, "kernel_launch: hipFuncSetAttribute failed\n"); grid = -1; return; }
        if (hipOccupancyMaxActiveBlocksPerMultiprocessor(&per_cu, (const void*)fwd_megakernel, NTHREADS, LDS_BYTES) != hipSuccess || per_cu < 1) { fprintf(stderr, "kernel_launch: occupancy query says %d blocks per CU\n", per_cu); (void)hipGetLastError(); grid = -1; return; }
        if (cus < 256) { fprintf(stderr, "kernel_launch: %d CUs < 256\n", cus); grid = -1; return; }
        grid = 256;
    }
    if (grid < 0) return;
    Args a{};
    for (int i = 0; i < 12; ++i) a.in[i] = (const float*)d_in[i];
    a.out = (float*)d_out; a.ws = (unsigned char*)d_ws;
    for (int i = 0; i < 8; ++i) a.inv_freq[i] = powf(500000.0f, -(float)(2 * i) / 16.0f);
    if (hipMemsetAsync((char*)d_ws + WS_BAR, 0, 65536, stream) != hipSuccess) { fprintf(stderr, "kernel_launch: memset failed\n"); return; }
    void* args[] = {&a};
    hipError_t e = hipLaunchCooperativeKernel((const void*)fwd_megakernel, dim3(grid), dim3(NTHREADS), args, LDS_BYTES, stream);
    if (e != hipSuccess) fprintf(stderr, "kernel_launch: cooperative launch failed: %s\n", hipGetErrorString(e));
}
```
